# Optimizing an MI355X kernel written in HIP

```python
import math
import jax, jax.numpy as jnp
from jax import lax
import numpy as np

D_MODEL = 1024
BATCH = 16
SEQ = 2048
DEPTH = 1

CHUNK = 64
Q_BLOCK = 128
PLE_DIM = 256
D_FF = 4 * D_MODEL
EPS = 1e-6

GLA_HEADS = 4
GLA_DK = D_MODEL // 16
GLA_DV = D_MODEL // 8
GLA_GATE_RANK = 16
GLA_TAU = 16.0
GLA_WIDTH = GLA_HEADS * GLA_DV

MLA_HEADS = 8
MLA_NOPE = 64
MLA_ROPE = 32
MLA_V = 64
MLA_QK = MLA_NOPE + MLA_ROPE
MLA_Q_RANK = 256
MLA_KV_RANK = 128
MLA_WIDTH = MLA_HEADS * MLA_V
ROPE_THETA = 10000.0

D_MIX = GLA_WIDTH + MLA_WIDTH
IN_SPLITS = (GLA_HEADS * GLA_DK, GLA_HEADS * GLA_DK, GLA_WIDTH, GLA_GATE_RANK,
             GLA_WIDTH, MLA_Q_RANK, MLA_KV_RANK, MLA_ROPE)
D_IN = (GLA_HEADS * GLA_DK * 2 + GLA_WIDTH * 2 + GLA_GATE_RANK
        + MLA_Q_RANK + MLA_KV_RANK + MLA_ROPE)

kernel_name = "hymba_gla_mla_hybrid_block"


def rms_norm(x, g):
    xf = x.astype(jnp.float32)
    y = xf * lax.rsqrt(jnp.mean(xf * xf, axis=-1, keepdims=True) + EPS)
    return (y * g.astype(jnp.float32)).astype(x.dtype)


def split_cols(t, sizes):
    out, start = [], 0
    for s in sizes:
        out.append(t[..., start:start + s])
        start += s
    return out


def rope_cos_sin(positions):
    inv_freq = ROPE_THETA ** (-jnp.arange(0, MLA_ROPE, 2, dtype=jnp.float32) / MLA_ROPE)
    ang = positions.astype(jnp.float32)[..., None] * inv_freq
    return jnp.cos(ang)[:, :, None, :], jnp.sin(ang)[:, :, None, :]


def apply_rope(x, cos, sin):
    half = x.shape[-1] // 2
    x1, x2 = x[..., :half], x[..., half:]
    c, s = cos.astype(x.dtype), sin.astype(x.dtype)
    return jnp.concatenate([x1 * c - x2 * s, x2 * c + x1 * s], axis=-1)


def gla_chunked(q, k, v, log_a):
    out_dtype = v.dtype
    B, S, H, DK = q.shape
    DV = v.shape[-1]
    NC = S // CHUNK

    def to_chunks(t):
        return t.astype(jnp.float32).reshape(B, NC, CHUNK, H, -1).transpose(1, 0, 3, 2, 4)

    qc, kc, vc, gc = to_chunks(q), to_chunks(k), to_chunks(v), to_chunks(log_a)
    causal = jnp.tril(jnp.ones((CHUNK, CHUNK), dtype=bool))[:, :, None]

    def step(state, inp):
        qi, ki, vi, gi = inp
        b = jnp.cumsum(gi, axis=2)
        b_last = b[:, :, -1:, :]
        o_inter = jnp.einsum('bhtk,bhkv->bhtv', qi * jnp.exp(b), state)
        diff = b[:, :, :, None, :] - b[:, :, None, :, :]
        decay = jnp.exp(jnp.where(causal, diff, -jnp.inf))
        scores = jnp.einsum('bhtk,bhsk,bhtsk->bhts', qi, ki, decay)
        o_intra = jnp.einsum('bhts,bhsv->bhtv', scores, vi)
        k_dec = ki * jnp.exp(b_last - b)
        state = state * jnp.exp(b_last[:, :, 0, :, None]) + jnp.einsum('bhsk,bhsv->bhkv', k_dec, vi)
        return state, o_inter + o_intra

    state0 = jnp.zeros((B, H, DK, DV), dtype=jnp.float32)
    _, oc = lax.scan(step, state0, (qc, kc, vc, gc))
    return oc.transpose(1, 0, 3, 2, 4).reshape(B, S, H, DV).astype(out_dtype)


def mla_attention(q, k, v):
    S = q.shape[1]
    scale = 1.0 / math.sqrt(MLA_QK)
    outs = []
    for blk in range(S // Q_BLOCK):
        qs, qe = blk * Q_BLOCK, (blk + 1) * Q_BLOCK
        qb, kb, vb = q[:, qs:qe], k[:, :qe], v[:, :qe]
        logits = jnp.einsum('bqhd,bkhd->bhqk', qb, kb).astype(jnp.float32) * scale
        q_chunk = (jnp.arange(qs, qe) // CHUNK)[:, None]
        k_chunk = (jnp.arange(qe) // CHUNK)[None, :]
        logits = jnp.where(k_chunk <= q_chunk, logits, -jnp.inf)
        probs = jax.nn.softmax(logits, axis=-1).astype(vb.dtype)
        outs.append(jnp.einsum('bhqk,bkhd->bqhd', probs, vb))
    return jnp.concatenate(outs, axis=1)


def setup_inputs(seed: int = 0) -> dict:
    key = jax.random.key(seed)
    ks = jax.random.split(key, 24)
    f32 = jnp.float32

    def w(k, shape, fan_in):
        return jax.random.normal(k, shape, f32) * (fan_in ** -0.5)

    def gain(k, shape):
        return 1.0 + 0.1 * jax.random.normal(k, shape, f32)

    x = jax.random.normal(ks[0], (BATCH, SEQ, D_MODEL), f32)
    p = jax.random.normal(ks[1], (DEPTH, BATCH, SEQ, PLE_DIM), f32)
    offset = jax.random.randint(ks[2], (BATCH,), 0, 64, dtype=jnp.int32) * CHUNK
    positions = (offset[:, None] + jnp.arange(SEQ, dtype=jnp.int32)[None, :]).astype(jnp.int32)
    return {
        "x": x,
        "p": p,
        "positions": positions,
        "attn_norm": gain(ks[3], (DEPTH, D_MODEL)),
        "w_in": w(ks[4], (DEPTH, D_MODEL, D_IN), D_MODEL),
        "gla_gate_w2": w(ks[5], (DEPTH, GLA_GATE_RANK, GLA_HEADS * GLA_DK), GLA_GATE_RANK),
        "gla_gate_b": 0.1 * jax.random.normal(ks[6], (DEPTH, GLA_HEADS * GLA_DK), f32),
        "gla_out_norm": gain(ks[7], (DEPTH, GLA_DV)),
        "mla_q_norm": gain(ks[8], (DEPTH, MLA_Q_RANK)),
        "mla_w_uq": w(ks[9], (DEPTH, MLA_Q_RANK, MLA_HEADS * MLA_QK), MLA_Q_RANK),
        "mla_kv_norm": gain(ks[10], (DEPTH, MLA_KV_RANK)),
        "mla_w_ukv": w(ks[11], (DEPTH, MLA_KV_RANK, MLA_HEADS * (MLA_NOPE + MLA_V)), MLA_KV_RANK),
        "qk_norm_q": gain(ks[12], (DEPTH, MLA_QK)),
        "qk_norm_k": gain(ks[13], (DEPTH, MLA_QK)),
        "w_out": w(ks[14], (DEPTH, D_MIX, D_MODEL), D_MIX),
        "mlp_norm": gain(ks[15], (DEPTH, D_MODEL)),
        "w_mlp_up": w(ks[16], (DEPTH, D_MODEL, D_FF), D_MODEL),
        "w_mlp_down": w(ks[17], (DEPTH, D_FF, D_MODEL), D_FF),
        "ple_norm": gain(ks[18], (DEPTH, D_MODEL)),
        "w_ple_gate": w(ks[19], (DEPTH, D_MODEL, D_MODEL), D_MODEL),
        "b_ple_gate": 0.1 * jax.random.normal(ks[20], (DEPTH, D_MODEL), f32),
        "w_ple_proj": w(ks[21], (DEPTH, PLE_DIM, D_MODEL), PLE_DIM),
    }


def reference(x, p, positions, attn_norm, w_in, gla_gate_w2, gla_gate_b, gla_out_norm,
              mla_q_norm, mla_w_uq, mla_kv_norm, mla_w_ukv, qk_norm_q, qk_norm_k,
              w_out, mlp_norm, w_mlp_up, w_mlp_down, ple_norm, w_ple_gate, b_ple_gate,
              w_ple_proj):
    B, S, _ = x.shape
    cos, sin = rope_cos_sin(positions)
    h = x
    for i in range(DEPTH):
        n = rms_norm(h, attn_norm[i])
        z = n @ w_in[i]
        gq, gk, gv, g_low, g_r, c_q, c_kv, k_r = split_cols(z, IN_SPLITS)

        q_g = gq.reshape(B, S, GLA_HEADS, GLA_DK) * (GLA_DK ** -0.5)
        k_g = gk.reshape(B, S, GLA_HEADS, GLA_DK)
        v_g = gv.reshape(B, S, GLA_HEADS, GLA_DV)
        log_a = jax.nn.log_sigmoid((g_low @ gla_gate_w2[i] + gla_gate_b[i]).astype(jnp.float32)) / GLA_TAU
        log_a = log_a.reshape(B, S, GLA_HEADS, GLA_DK)
        o_g = gla_chunked(q_g, k_g, v_g, log_a)
        o_g = rms_norm(o_g, gla_out_norm[i]).reshape(B, S, GLA_WIDTH) * jax.nn.silu(g_r)

        q_m = (rms_norm(c_q, mla_q_norm[i]) @ mla_w_uq[i]).reshape(B, S, MLA_HEADS, MLA_QK)
        kv = (rms_norm(c_kv, mla_kv_norm[i]) @ mla_w_ukv[i]).reshape(B, S, MLA_HEADS, MLA_NOPE + MLA_V)
        k_nope, v_m = kv[..., :MLA_NOPE], kv[..., MLA_NOPE:]
        k_rope = jnp.broadcast_to(k_r[:, :, None, :], (B, S, MLA_HEADS, MLA_ROPE))
        k_m = jnp.concatenate([k_nope, k_rope], axis=-1)
        q_m = rms_norm(q_m, qk_norm_q[i])
        k_m = rms_norm(k_m, qk_norm_k[i])
        q_m = jnp.concatenate([q_m[..., :MLA_NOPE], apply_rope(q_m[..., MLA_NOPE:], cos, sin)], axis=-1)
        k_m = jnp.concatenate([k_m[..., :MLA_NOPE], apply_rope(k_m[..., MLA_NOPE:], cos, sin)], axis=-1)
        o_m = mla_attention(q_m, k_m, v_m).reshape(B, S, MLA_WIDTH)

        h = h + jnp.concatenate([o_g, o_m], axis=-1) @ w_out[i]

        m = rms_norm(h, mlp_norm[i])
        h = h + jnp.square(jax.nn.relu(m @ w_mlp_up[i])) @ w_mlp_down[i]

        gate = jax.nn.sigmoid(rms_norm(h, ple_norm[i]) @ w_ple_gate[i] + b_ple_gate[i])
        h = h + (p[i] @ w_ple_proj[i]) * gate
    return h
```

```cpp
#define MK_N_LAUNCHES 9
#include <hip/hip_runtime.h>
#include <cstdio>
#include <cstdint>
namespace pg8 {
#define PG8_LAS __attribute__((address_space(3)))
typedef unsigned short bf16_t;
typedef short bf16x8 __attribute__((ext_vector_type(8)));
typedef float f32x4 __attribute__((ext_vector_type(4)));
typedef unsigned u32x4 __attribute__((ext_vector_type(4)));
constexpr int BM = 256, BK = 64, HALF = 128, HTB = HALF * BK * 2  , STAGE_BYTES = 8 * HTB, NXCD = 8, WGM = 8;

__host__ __device__ __forceinline__ int lds_byte(int r, int c) { const int st = (r >> 4) * 2 + (c >> 5), rr = r & 15, cc = c & 31, ob = rr * 64 + cc * 2; return st * 1024 + (ob ^ (((ob >> 9) & 1) << 5)); }
__host__ __device__ __forceinline__ void stage_rc(int b, int& R, int& C) { const int st = b / 1024, sb = b % 1024, swz = sb ^ (((sb >> 9) & 1) << 5); R = (st >> 1) * 16 + swz / 64; C = (st & 1) * 32 + (swz % 64) / 2; }
__host__ __device__ __forceinline__ int perm32(int rho) { const int n = rho >> 4, i = rho & 15; return 8 * (i >> 2) + 4 * n + (i & 3); }

struct Unit { int pm, pn; };
struct Gemm { const bf16_t* A; const bf16_t* Bt; int M, N, K; };

struct StaticOrder {
    int nM, nN, nwg, G, c;
    __host__ __device__ void init(int M, int N, int G_, int c_) { nM = M / BM; nN = N / BM; nwg = nM * nN; G = G_; c = c_; }
    __host__ __device__ bool next(int i, Unit& u) const {
        const long L = (long)i * G + c; if (L >= nwg) return false;
        int wgid = (int)L; { const int q = nwg / NXCD, r = nwg % NXCD, xcd = wgid % NXCD, off = wgid / NXCD; wgid = (xcd < r ? xcd * (q + 1) : r * (q + 1) + (xcd - r) * q) + off; }
        const int nig = WGM * nN, gid = wgid / nig, fm = gid * WGM, gsz = (nM - fm) < WGM ? (nM - fm) : WGM;
        u.pm = fm + ((wgid % nig) % gsz); u.pn = (wgid % nig) / gsz; return true;
    }
    __device__ __forceinline__ void a_ready(const Unit&) const {}
    __device__ __forceinline__ void done(const Unit&) const {}
};

__device__ __forceinline__ unsigned cvt_pk_bf16(float lo, float hi) { unsigned r; asm volatile("v_cvt_pk_bf16_f32 %0, %1, %2" : "=v"(r) : "v"(lo), "v"(hi)); return r; }
typedef float f32x2 __attribute__((ext_vector_type(2)));
typedef unsigned u32x2 __attribute__((ext_vector_type(2)));
constexpr float RMS_EPS = 1e-6f;
template <int MODE> struct EpiBf {
    static constexpr bool PERM = true, AFTER_DRAIN = false;
    bf16_t* O; int ldc; const float* rs;
    __device__ __forceinline__ void operator()(const f32x4 (&acc)[2][2][4][2], const Unit& u, int wr, int wc, int fr, int fq) const {
        const int row0 = u.pm * BM + wr * 64 + fr, col0 = u.pn * BM + wc * 32 + 8 * fq;
#pragma unroll
        for (int ai = 0; ai < 2; ++ai)
#pragma unroll
            for (int m = 0; m < 4; ++m) { const int row = row0 + ai * HALF + m * 16; bf16_t* rowp = O + (size_t)row * ldc + col0;
                float s = 1.f; if (MODE == 0) s = rs[row]; if (MODE == 1) s = __builtin_amdgcn_rsqf(rs[row] * (1.f / 1024.f) + RMS_EPS);
#pragma unroll
                for (int bj = 0; bj < 2; ++bj) { f32x4 v0 = acc[ai][bj][m][0] * s, v1 = acc[ai][bj][m][1] * s;
                    if (MODE == 1) {
#pragma unroll
                        for (int e = 0; e < 4; ++e) { const float a = fmaxf(v0[e], 0.f), b = fmaxf(v1[e], 0.f); v0[e] = a * a; v1[e] = b * b; } }
                    u32x4 w; w.x = cvt_pk_bf16(v0[0], v0[1]); w.y = cvt_pk_bf16(v0[2], v0[3]); w.z = cvt_pk_bf16(v1[0], v1[1]); w.w = cvt_pk_bf16(v1[2], v1[3]);
                    *(u32x4*)(rowp + bj * HALF) = w; } }
    }
};
struct EpiRes {
    static constexpr bool PERM = false, AFTER_DRAIN = false;
    const float* base; float* out; bf16_t* ob; float* ssq; int ldc;
    __device__ __forceinline__ void operator()(const f32x4 (&acc)[2][2][4][2], const Unit& u, int wr, int wc, int fr, int fq) const {
        const int col0 = u.pn * BM + wc * 32 + 4 * fq;
#pragma unroll
        for (int ai = 0; ai < 2; ++ai)
#pragma unroll
            for (int m = 0; m < 4; ++m) { const int row = u.pm * BM + ai * HALF + wr * 64 + m * 16 + fr; const size_t off = (size_t)row * ldc + col0; float q = 0.f;
#pragma unroll
                for (int bj = 0; bj < 2; ++bj)
#pragma unroll
                    for (int n = 0; n < 2; ++n) { const size_t o2 = off + bj * HALF + n * 16; const f32x4 b = *(const f32x4*)(base + o2); const f32x4 h = b + acc[ai][bj][m][n];
                        *(f32x4*)(out + o2) = h; q += (h[0] * h[0] + h[1] * h[1]) + (h[2] * h[2] + h[3] * h[3]);
                        u32x2 w; w.x = cvt_pk_bf16(h[0], h[1]); w.y = cvt_pk_bf16(h[2], h[3]); *(u32x2*)(ob + o2) = w; }
                q += __shfl_xor(q, 16); q += __shfl_xor(q, 32);
                if (fq == 0) atomicAdd(ssq + row, q);
                asm volatile("" ::: "memory"); }
    }
};
struct EpiGate {
    static constexpr bool PERM = false, AFTER_DRAIN = false;
    const float* ssq; const float* bias; const bf16_t* pp; float* out; int ldc;
    __device__ __forceinline__ void operator()(const f32x4 (&acc)[2][2][4][2], const Unit& u, int wr, int wc, int fr, int fq) const {
        const int col0 = u.pn * BM + wc * 32 + 4 * fq;
        f32x4 bv[2][2];
#pragma unroll
        for (int bj = 0; bj < 2; ++bj)
#pragma unroll
            for (int n = 0; n < 2; ++n) bv[bj][n] = *(const f32x4*)(bias + col0 + bj * HALF + n * 16);
#pragma unroll
        for (int ai = 0; ai < 2; ++ai)
#pragma unroll
            for (int m = 0; m < 4; ++m) { const int row = u.pm * BM + ai * HALF + wr * 64 + m * 16 + fr; const size_t off = (size_t)row * ldc + col0;
                const float s = __builtin_amdgcn_rsqf(ssq[row] * (1.f / 1024.f) + RMS_EPS);
#pragma unroll
                for (int bj = 0; bj < 2; ++bj)
#pragma unroll
                    for (int n = 0; n < 2; ++n) { const size_t o2 = off + bj * HALF + n * 16; const f32x4 h = *(const f32x4*)(out + o2); const u32x2 pw = *(const u32x2*)(pp + o2);
                        const f32x4 y = acc[ai][bj][m][n] * s + bv[bj][n];
                        f32x4 pf; pf[0] = __uint_as_float(pw.x << 16); pf[1] = __uint_as_float(pw.x & 0xffff0000u); pf[2] = __uint_as_float(pw.y << 16); pf[3] = __uint_as_float(pw.y & 0xffff0000u);
                        f32x4 o;
#pragma unroll
                        for (int e = 0; e < 4; ++e) { const float g = __builtin_amdgcn_rcpf(1.f + __builtin_amdgcn_exp2f(-1.4426950408889634f * y[e])); o[e] = h[e] + pf[e] * g; }
                        *(f32x4*)(out + o2) = o; }
                asm volatile("" ::: "memory"); }
    }
};
template <class Epi, class Sched, bool ALIGN_EPI = false, bool SP2 = false>
__device__ __forceinline__ void gemm_phase(PG8_LAS unsigned char* lds, const Gemm g, const Sched& S, const Epi& E) {
    const int tid = threadIdx.x, wid = __builtin_amdgcn_readfirstlane(tid >> 6), lane = tid & 63, wr = wid >> 2, wc = wid & 3, fr = lane & 15, fq = lane >> 4;
    const int K = g.K, nt = K / BK;
    unsigned voffA[2], voffB[2];
#pragma unroll
    for (int i = 0; i < 2; ++i) { int R, C; stage_rc(tid * 16 + i * 8192, R, C); const int Rb = Epi::PERM ? ((R & ~31) + perm32(R & 31)) : R;
        voffA[i] = (unsigned)(R * K + C) * 2u; voffB[i] = (unsigned)(Rb * K + C) * 2u; }
    const size_t kstep = (size_t)(BK * 2);
    const size_t hstep = (size_t)HALF * K * 2;
    const size_t tstep = 2 * hstep;
    const unsigned ldsw = (unsigned)wid * 1024u;
    const int aoff = lds_byte(wr * 64 + fr, fq * 8), boff = lds_byte(wc * 32 + fr, fq * 8);
#define PG8_SA(b, h) (((b) * 2 + (h)) * HTB)
#define PG8_SB(b, h) ((4 + (b) * 2 + (h)) * HTB)
#define PG8_STAGE(bufoff, gbase, voff) do { _Pragma("unroll") for (int _i = 0; _i < 2; ++_i) \
        __builtin_amdgcn_global_load_lds((const unsigned*)((const char*)(gbase) + (voff)[_i]), (PG8_LAS unsigned*)(lds + (bufoff) + ldsw + _i * 8192), 16, 0, 0); } while (0)
#define PG8_LDA(dst, b, h) do { _Pragma("unroll") for (int m = 0; m < 4; ++m) _Pragma("unroll") for (int k = 0; k < 2; ++k) dst[m][k] = *(const PG8_LAS bf16x8*)(lds + PG8_SA(b, h) + aoff + m * 2048 + k * 1024); } while (0)
#define PG8_LDB(dst, b, h) do { _Pragma("unroll") for (int n = 0; n < 2; ++n) _Pragma("unroll") for (int k = 0; k < 2; ++k) dst[n][k] = *(const PG8_LAS bf16x8*)(lds + PG8_SB(b, h) + boff + n * 2048 + k * 1024); } while (0)
#define PG8_MMA(ai, bj, At, Bt) do { __builtin_amdgcn_s_setprio(1); _Pragma("unroll") for (int m = 0; m < 4; ++m) _Pragma("unroll") for (int n = 0; n < 2; ++n) _Pragma("unroll") for (int k = 0; k < 2; ++k) \
        acc[ai][bj][m][n] = __builtin_amdgcn_mfma_f32_16x16x32_bf16(Bt[n][k], At[m][k], acc[ai][bj][m][n], 0, 0, 0); __builtin_amdgcn_s_setprio(0); } while (0)
#define PG8_WAIT_V(n) asm volatile("s_waitcnt vmcnt(" #n ")" ::: "memory")
#define PG8_WAIT_L(n) asm volatile("s_waitcnt lgkmcnt(" #n ")" ::: "memory")
#define PG8_BAR __builtin_amdgcn_s_barrier()
#define PG8_SCHED __builtin_amdgcn_sched_barrier(0)
    Unit cur, nxt; int ui = 0;
    if (!S.next(0, cur)) return;
    f32x4 acc[2][2][4][2];
#pragma unroll
    for (int a = 0; a < 2; ++a)
#pragma unroll
        for (int b = 0; b < 2; ++b)
#pragma unroll
            for (int m = 0; m < 4; ++m)
#pragma unroll
                for (int n = 0; n < 2; ++n) acc[a][b][m][n] = (f32x4){0.f, 0.f, 0.f, 0.f};
    bf16x8 At[4][2], B0[2][2], B1[2][2];
    const char* cA = (const char*)g.A + (size_t)cur.pm * tstep; const char* cB = (const char*)g.Bt + (size_t)cur.pn * tstep;
    S.a_ready(cur);
    if constexpr (SP2) {
        PG8_STAGE(PG8_SB(0, 0), cB, voffB); PG8_STAGE(PG8_SB(0, 1), cB + hstep, voffB); PG8_STAGE(PG8_SA(0, 0), cA, voffA); PG8_STAGE(PG8_SA(0, 1), cA + hstep, voffA);
        if (wr == 1) PG8_BAR;
        PG8_WAIT_V(2); PG8_BAR;
        PG8_STAGE(PG8_SB(1, 0), cB + kstep, voffB); PG8_STAGE(PG8_SA(1, 0), cA + kstep, voffA); PG8_STAGE(PG8_SB(1, 1), cB + hstep + kstep, voffB);
        PG8_WAIT_V(6); PG8_BAR;
    } else {
        PG8_STAGE(PG8_SB(0, 0), cB, voffB); PG8_STAGE(PG8_SA(0, 0), cA, voffA); PG8_STAGE(PG8_SB(0, 1), cB + hstep, voffB); PG8_STAGE(PG8_SA(0, 1), cA + hstep, voffA);
        if (wr == 1) PG8_BAR;
        PG8_WAIT_V(4); PG8_BAR;
        PG8_STAGE(PG8_SB(1, 0), cB + kstep, voffB); PG8_STAGE(PG8_SA(1, 0), cA + kstep, voffA); PG8_STAGE(PG8_SB(1, 1), cB + hstep + kstep, voffB);
        PG8_WAIT_V(6); PG8_BAR;
    }
    for (;;) {
        const bool has_next = S.next(ui + 1, nxt);
        const char* nA = has_next ? (const char*)g.A + (size_t)nxt.pm * tstep : cA; const char* nB = has_next ? (const char*)g.Bt + (size_t)nxt.pn * tstep : cB;
        for (int t = 0; t < nt; t += 2) {
            const bool last = (t == nt - 2);
            const char* a1 = cA + (size_t)(t + 1) * kstep;
            const char* a2 = last ? nA : cA + (size_t)(t + 2) * kstep; const char* b2 = last ? nB : cB + (size_t)(t + 2) * kstep;
            const char* a3 = a2 + kstep; const char* b3 = b2 + kstep;
            if (last && has_next) S.a_ready(nxt);
            if constexpr (SP2) {
            PG8_LDB(B0, 0, 0); PG8_LDB(B1, 0, 1); PG8_SCHED; PG8_LDA(At, 0, 0); PG8_STAGE(PG8_SA(1, 1), a1 + hstep, voffA);
            PG8_WAIT_V(8); PG8_WAIT_L(0); PG8_BAR; PG8_MMA(0, 0, At, B0); PG8_MMA(0, 1, At, B1); PG8_BAR; PG8_SCHED;
            PG8_LDA(At, 0, 1); PG8_STAGE(PG8_SB(0, 0), b2, voffB); PG8_STAGE(PG8_SB(0, 1), b2 + hstep, voffB); PG8_STAGE(PG8_SA(0, 0), a2, voffA);
            PG8_WAIT_V(8); PG8_WAIT_L(0); PG8_BAR; PG8_MMA(1, 0, At, B0); PG8_MMA(1, 1, At, B1); PG8_BAR; PG8_SCHED;
            PG8_LDB(B0, 1, 0); PG8_LDB(B1, 1, 1); PG8_SCHED; PG8_LDA(At, 1, 0); PG8_STAGE(PG8_SA(0, 1), a2 + hstep, voffA);
            PG8_WAIT_V(8); PG8_WAIT_L(0); PG8_BAR; PG8_MMA(0, 0, At, B0); PG8_MMA(0, 1, At, B1); PG8_BAR; PG8_SCHED;
            PG8_LDA(At, 1, 1); PG8_STAGE(PG8_SB(1, 0), b3, voffB); PG8_STAGE(PG8_SB(1, 1), b3 + hstep, voffB); PG8_STAGE(PG8_SA(1, 0), a3, voffA);
            PG8_WAIT_V(8); PG8_WAIT_L(0); PG8_BAR; PG8_MMA(1, 0, At, B0); PG8_MMA(1, 1, At, B1); PG8_BAR; PG8_SCHED;
            } else {
            PG8_LDB(B0, 0, 0); PG8_SCHED; PG8_LDA(At, 0, 0); PG8_STAGE(PG8_SA(1, 1), a1 + hstep, voffA);
            PG8_WAIT_L(8); PG8_BAR; PG8_WAIT_L(0); PG8_MMA(0, 0, At, B0); PG8_BAR; PG8_SCHED;
            PG8_LDB(B1, 0, 1); PG8_STAGE(PG8_SB(0, 0), b2, voffB);
            PG8_BAR; PG8_WAIT_L(0); PG8_MMA(0, 1, At, B1); PG8_BAR;
            PG8_LDA(At, 0, 1); PG8_STAGE(PG8_SA(0, 0), a2, voffA);
            PG8_BAR; PG8_WAIT_L(0); PG8_MMA(1, 0, At, B0); PG8_BAR; PG8_SCHED;
            PG8_STAGE(PG8_SB(0, 1), b2 + hstep, voffB);
            PG8_WAIT_V(6); PG8_BAR; PG8_MMA(1, 1, At, B1); PG8_BAR;
            PG8_LDB(B0, 1, 0); PG8_SCHED; PG8_LDA(At, 1, 0); PG8_STAGE(PG8_SA(0, 1), a2 + hstep, voffA);
            PG8_WAIT_L(8); PG8_BAR; PG8_WAIT_L(0); PG8_MMA(0, 0, At, B0); PG8_BAR; PG8_SCHED;
            PG8_LDB(B1, 1, 1); PG8_STAGE(PG8_SB(1, 0), b3, voffB);
            PG8_BAR; PG8_WAIT_L(0); PG8_MMA(0, 1, At, B1); PG8_BAR;
            PG8_LDA(At, 1, 1); PG8_STAGE(PG8_SA(1, 0), a3, voffA);
            PG8_BAR; PG8_WAIT_L(0); PG8_MMA(1, 0, At, B0); PG8_BAR; PG8_SCHED;
            PG8_STAGE(PG8_SB(1, 1), b3 + hstep, voffB);
            PG8_WAIT_V(6); PG8_BAR; PG8_MMA(1, 1, At, B1); PG8_BAR;
            }
        }
        if constexpr (ALIGN_EPI) { if (wr == 0) PG8_BAR; }
        if constexpr (!Epi::AFTER_DRAIN) { E(acc, cur, wr, wc, fr, fq); S.done(cur); }
        if (!has_next) break;
#pragma unroll
        for (int a = 0; a < 2; ++a)
#pragma unroll
            for (int b = 0; b < 2; ++b)
#pragma unroll
                for (int m = 0; m < 4; ++m)
#pragma unroll
                    for (int n = 0; n < 2; ++n) acc[a][b][m][n] = (f32x4){0.f, 0.f, 0.f, 0.f};
        cur = nxt; cA = nA; cB = nB; ++ui;
        if constexpr (ALIGN_EPI) { if (wr == 1) PG8_BAR; }
    }
    PG8_WAIT_V(0);
    if constexpr (!ALIGN_EPI) { if (wr == 0) PG8_BAR; }
    PG8_BAR;
    if constexpr (Epi::AFTER_DRAIN) { E.fused(acc, cur, wr, wc, fr, fq, lds, wid, lane); S.done(cur); }
#undef PG8_SA
#undef PG8_SB
#undef PG8_STAGE
#undef PG8_LDA
#undef PG8_LDB
#undef PG8_MMA
#undef PG8_WAIT_V
#undef PG8_WAIT_L
#undef PG8_BAR
#undef PG8_SCHED
}
}
constexpr int NWAVES = 8;
#ifndef MK_N_LAUNCHES
#define MK_N_LAUNCHES 1
#endif
constexpr int NPH = 9;
constexpr int N_LAUNCHES = MK_N_LAUNCHES;
#ifndef FAST_PREP
#define FAST_PREP 0
#endif
#ifndef FAST_ATTN
#define FAST_ATTN 0
#endif
#ifndef FAST_GLA
#define FAST_GLA 0
#endif
constexpr int BATCH = 16, SEQ = 2048, DM = 1024, M = BATCH * SEQ, FF = 4096, PLE = 256, ZW = 2048;
constexpr int Z_GQ = 0, Z_GK = 256, Z_GV = 512, Z_GR = 1024, Z_CQ = 1536, Z_CKV = 1792, Z_KR = 1920, Z_GL = 1952;
constexpr int MH = 8, QKD = 96, VD = 64;
constexpr float EPS = 1e-6f;
constexpr float QSCALE = 0.10206207261596577f * 1.4426950408889634f;
constexpr size_t MiB = 1u << 20;
constexpr size_t WS_CTL = 0, CTL_ZERO_BYTES = 1 * MiB;
constexpr size_t CTL_SSQ2 = 256 * 1024, CTL_SSQ3 = 512 * 1024;
constexpr size_t WS_RS1 = 1 * MiB;
constexpr size_t WS_ROPE = 2 * MiB;
constexpr size_t WS_DEC = 6 * MiB;
constexpr size_t WS_WIN = 8 * MiB, WS_WOUT = 12 * MiB, WS_WUP = 14 * MiB, WS_WDN = 22 * MiB, WS_WG = 30 * MiB, WS_WP = 32 * MiB, WS_WUQ = 33 * MiB, WS_WUKV = 34 * MiB;
constexpr size_t WS_PB = 36 * MiB;
constexpr size_t WS_US = 52 * MiB;
constexpr size_t WS_Q = 84 * MiB, WS_K = 132 * MiB, WS_V = 180 * MiB;
constexpr size_t WS_PP = 52 * MiB;
constexpr size_t WS_H1B = 116 * MiB;
constexpr size_t WS_H2B = 180 * MiB;
constexpr size_t WS_XB = 244 * MiB;
constexpr size_t WS_Z = 308 * MiB;
constexpr size_t WS_MIX = 436 * MiB;
constexpr size_t WS_HID = 244 * MiB;
constexpr size_t WS_END = 500 * MiB;
constexpr int CW_TMO = 0, CW_CODE = 1, CW_BAR = 4096;
constexpr int RING_OFF = 0, RING_BYTES = 131072;
constexpr int LDSCTL_OFF = RING_BYTES, MISC_OFF = LDSCTL_OFF + 320;
constexpr int LDS_BYTES = 147456;
static_assert(MISC_OFF + 128 <= LDS_BYTES, "LDS map");
#define GAS __attribute__((address_space(1)))
#define LAS __attribute__((address_space(3)))
typedef unsigned short bf16;
typedef unsigned v4u __attribute__((ext_vector_type(4)));
typedef float f32x4 __attribute__((ext_vector_type(4)));
typedef short bf16x8 __attribute__((ext_vector_type(8)));
typedef GAS unsigned gu32;
typedef GAS unsigned long long gu64;
#define RLX_AGENT __ATOMIC_RELAXED, __HIP_MEMORY_SCOPE_AGENT
#define LDS_WAIT() asm volatile("s_waitcnt lgkmcnt(0)" ::: "memory")
#define VM_WAIT() asm volatile("s_waitcnt vmcnt(0)" ::: "memory")
__device__ __forceinline__ unsigned long long rt() { return __builtin_amdgcn_s_memrealtime(); }
__device__ __forceinline__ unsigned f2bf(float f) { unsigned u = __builtin_bit_cast(unsigned, f); return (u + 0x7fffu + ((u >> 16) & 1u)) >> 16; }
__device__ __forceinline__ unsigned pk2(float lo, float hi) { return f2bf(lo) | (f2bf(hi) << 16); }

#define XB_TMO      128
#define XB_XCNT(j)  (256  + 64 * (j))
#define XB_XSUB(j)  (1280 + 64 * (j))
#define XB_XGEN(j)  (2304 + 64 * (j))
#define XB_TOP      3328
#define XB_TOPGEN   3392
#define XCD_BAR_WORDS 3456
#define XB_SPIN_CAP (1u << 18)

__device__ __forceinline__ unsigned xb_ld(unsigned* p)              { return __hip_atomic_load(p, __ATOMIC_RELAXED, __HIP_MEMORY_SCOPE_AGENT); }
__device__ __forceinline__ unsigned xb_add(unsigned* p, unsigned v) { return __hip_atomic_fetch_add(p, v, __ATOMIC_RELAXED, __HIP_MEMORY_SCOPE_AGENT); }
__device__ __forceinline__ unsigned xb_xcc_id() { return (unsigned)__builtin_amdgcn_s_getreg((3 << 11) | 20) & 0xFu; }
#define XB_SPIN(cond, bar) do { unsigned _sp = 0; while (cond) { __builtin_amdgcn_s_sleep(1); \
    if ((++_sp & 255u) == 0u) { if (xb_ld(&(bar)[XB_TMO])) break; if (_sp > XB_SPIN_CAP) { atomicAdd(&(bar)[XB_TMO], 1u); break; } } } } while (0)

struct XcdBarrier {
    unsigned* bar; unsigned x;
    volatile LAS unsigned* st;
};

__device__ __forceinline__ XcdBarrier xcd_barrier_post(unsigned* bar, volatile LAS unsigned* st) {
    XcdBarrier b; b.bar = bar; b.x = xb_xcc_id(); b.st = st;
    if (threadIdx.x == 0) (void)xb_add(&bar[XB_XCNT(b.x)], 1u);
    return b;
}
__device__ __forceinline__ void xcd_barrier_complete(unsigned* bar, unsigned x, unsigned& nloc, unsigned& nx) {
    const unsigned G = gridDim.x * gridDim.y * gridDim.z;
    unsigned sum, cnt, mine, sp = 0u;
    for (;;) {
        sum = 0u; cnt = 0u; mine = 0u;
#pragma unroll
        for (unsigned j = 0; j < 16; ++j) { const unsigned c = xb_ld(&bar[XB_XCNT(j)]); sum += c; cnt += (c > 0u) ? 1u : 0u; mine = (j == x) ? c : mine; }
        if (sum == G) break;
        __builtin_amdgcn_s_sleep(1);
        if ((++sp & 255u) == 0u) { if (xb_ld(&bar[XB_TMO])) break; if (sp > XB_SPIN_CAP) { atomicAdd(&bar[XB_TMO], 1u); break; } }
    }
    nloc = mine > 0u ? mine : 1u; nx = cnt > 0u ? cnt : 1u;
}

__device__ __forceinline__ void xcd_barrier(const XcdBarrier& b) {
    asm volatile("s_waitcnt vmcnt(0)" ::: "memory");
    __syncthreads();
    if (threadIdx.x == 0) {
        unsigned* bar = b.bar;
        __builtin_amdgcn_s_waitcnt(0);
        unsigned nloc = b.st[0], nx = b.st[1];
        if (nloc == 0u) { xcd_barrier_complete(bar, b.x, nloc, nx); b.st[0] = nloc; b.st[1] = nx; }
        const unsigned old = xb_add(&bar[XB_XSUB(b.x)], 1u);
        const unsigned gen = old / nloc;
        if (old + 1u == (gen + 1u) * nloc) {
            __builtin_amdgcn_fence(__ATOMIC_RELEASE, "agent");
            asm volatile("s_waitcnt vmcnt(0)" ::: "memory");
            const unsigned og = xb_add(&bar[XB_TOP], 1u);
            const unsigned tg = og / nx;
            if (og + 1u == (tg + 1u) * nx) xb_add(&bar[XB_TOPGEN], 1u);
            else XB_SPIN(xb_ld(&bar[XB_TOPGEN]) == tg, bar);
            __builtin_amdgcn_fence(__ATOMIC_ACQUIRE, "agent");
            xb_add(&bar[XB_XGEN(b.x)], 1u);
            asm volatile("s_waitcnt vmcnt(0)" ::: "memory");
        } else {
            XB_SPIN(xb_ld(&bar[XB_XGEN(b.x)]) == gen, bar);
            __builtin_amdgcn_fence(__ATOMIC_ACQUIRE, "agent");
            asm volatile("s_waitcnt vmcnt(0)" ::: "memory");
        }
    }
    __syncthreads();
}
struct Frame {
    LAS unsigned char* lds;
    unsigned char* ldsg;
    volatile LAS unsigned* MISC;
    gu32* ctl;
    int tid, lane, wave;
    int vcu, G;
    const float *x, *p; const int* pos;
    const float *attn_norm, *w_in, *w2, *gb, *gon, *qn, *wuq, *kvn, *wukv, *nq, *nk, *w_out, *mlp_norm, *w_up, *w_dn, *ple_norm, *w_g, *b_g, *w_p;
    float* out; unsigned char* ws;
};
__device__ __forceinline__ float wave_sum(float v) {
#pragma unroll
    for (int o = 1; o < 64; o <<= 1) v += __shfl_xor(v, o);
    return v;
}
__device__ __forceinline__ float bf2f(bf16 h) { return __uint_as_float((unsigned)h << 16); }
__device__ __forceinline__ float bflo(unsigned w) { return __uint_as_float(w << 16); }
__device__ __forceinline__ float bfhi(unsigned w) { return __uint_as_float(w & 0xffff0000u); }
__device__ __forceinline__ float logsigmoidf(float y) { return fminf(y, 0.f) - log1pf(__expf(-fabsf(y))); }

__device__ __forceinline__ int zmap(int c) { return c < 1024 ? c : (c < 1952 ? c + 16 : (c < 1968 ? c - 928 : -1)); }
template <bool ZMAP> __device__ __forceinline__ void p0_transpose_item(const float* W, int K, int Nsrc, int Ndst, const float* gain, bf16* WT, LAS float* scr, int item, int lane) {
    const int nblk = Ndst / 32, kb = item / nblk, nb = item % nblk, k0 = 64 * kb, n0 = 32 * nb;
    const int sc = ZMAP ? zmap(n0 + (lane & 31)) : n0 + (lane & 31);
#pragma unroll 8
    for (int i = 0; i < 32; ++i) { const int kk = 2 * i + (lane >> 5); float v = 0.f; if (sc >= 0) { v = W[(size_t)(k0 + kk) * Nsrc + sc]; if (gain) v *= gain[k0 + kk]; } scr[kk * 33 + (lane & 31)] = v; }
    LDS_WAIT(); asm volatile("" ::: "memory");
    const int c = lane & 7;
#pragma unroll
    for (int j = 0; j < 4; ++j) { const int n = (lane >> 3) + 8 * j; const LAS float* s = scr + (8 * c) * 33 + n;
        v4u o; o.x = pk2(s[0 * 33], s[1 * 33]); o.y = pk2(s[2 * 33], s[3 * 33]); o.z = pk2(s[4 * 33], s[5 * 33]); o.w = pk2(s[6 * 33], s[7 * 33]);
        *(GAS v4u*)(WT + (size_t)(n0 + n) * K + k0 + 8 * c) = o; }
    LDS_WAIT(); asm volatile("" ::: "memory");
}
__device__ __forceinline__ void p0_prologue(Frame& F) {
    LAS float* scr = (LAS float*)(F.lds + RING_OFF + F.wave * 16384);
    const int gw = F.vcu * NWAVES + F.wave, NGW = F.G * NWAVES;
    unsigned char* ws = F.ws;
    constexpr int I_IN = 16 * 64, I_OUT = 16 * 32, I_UP = 16 * 128, I_DN = 64 * 32, I_G = 16 * 32, I_P = 4 * 32;
    constexpr int NITEMS = I_IN + I_OUT + I_UP + I_DN + I_G + I_P;
    for (int it = gw; it < NITEMS; it += NGW) {
        int r = it;
        if (r < I_IN) { p0_transpose_item<true>(F.w_in, 1024, 1968, 2048, F.attn_norm, (bf16*)(ws + WS_WIN), scr, r, F.lane); continue; } r -= I_IN;
        if (r < I_OUT) { p0_transpose_item<false>(F.w_out, 1024, 1024, 1024, nullptr, (bf16*)(ws + WS_WOUT), scr, r, F.lane); continue; } r -= I_OUT;
        if (r < I_UP) { p0_transpose_item<false>(F.w_up, 1024, 4096, 4096, F.mlp_norm, (bf16*)(ws + WS_WUP), scr, r, F.lane); continue; } r -= I_UP;
        if (r < I_DN) { p0_transpose_item<false>(F.w_dn, 4096, 1024, 1024, nullptr, (bf16*)(ws + WS_WDN), scr, r, F.lane); continue; } r -= I_DN;
        if (r < I_G) { p0_transpose_item<false>(F.w_g, 1024, 1024, 1024, F.ple_norm, (bf16*)(ws + WS_WG), scr, r, F.lane); continue; } r -= I_G;
        p0_transpose_item<false>(F.w_p, 256, 1024, 1024, nullptr, (bf16*)(ws + WS_WP), scr, r, F.lane);
    }
    { const int gt = gw * 64 + F.lane, NT = NGW * 64;
      for (int idx = gt; idx < 24576 + 16384; idx += NT) {
        const bool isq = idx < 24576; const int id2 = isq ? idx : idx - 24576; const int f = id2 >> 6, l = id2 & 63, r = l & 31, hi = l >> 5;
        int n, k0, N; const float* W; const float* g;
        if (isq) { const int h = f / 48, nb = (f / 16) % 3, ks = f % 16; n = h * 96 + 32 * nb + r; k0 = 16 * ks + 8 * hi; N = 768; W = F.wuq; g = F.qn; }
        else { const int h = f / 32, nb = (f / 8) % 4, ks = f % 8; n = h * 128 + 32 * nb + r; k0 = 16 * ks + 8 * hi; N = 1024; W = F.wukv; g = F.kvn; }
        float v[8];
#pragma unroll
        for (int j = 0; j < 8; ++j) v[j] = W[(size_t)(k0 + j) * N + n] * g[k0 + j];
        v4u o; o.x = pk2(v[0], v[1]); o.y = pk2(v[2], v[3]); o.z = pk2(v[4], v[5]); o.w = pk2(v[6], v[7]);
        *(GAS v4u*)((isq ? ws + WS_WUQ : ws + WS_WUKV) + (size_t)id2 * 16) = o; } }
    for (int m = gw; m < M; m += NGW) {
        const GAS f32x4* xr = (const GAS f32x4*)(F.x + (size_t)m * DM) + F.lane;
        f32x4 v[4]; float s = 0.f;
#pragma unroll
        for (int j = 0; j < 4; ++j) { v[j] = xr[64 * j]; s += (v[j].x * v[j].x + v[j].y * v[j].y) + (v[j].z * v[j].z + v[j].w * v[j].w); }
        s = wave_sum(s);
        if (F.lane == 0) ((float*)(ws + WS_RS1))[m] = 1.0f / sqrtf(s * (1.f / DM) + EPS);
        GAS unsigned long long* o8 = (GAS unsigned long long*)((bf16*)(ws + WS_XB) + (size_t)m * DM) + F.lane;
#pragma unroll
        for (int j = 0; j < 4; ++j) o8[64 * j] = (unsigned long long)pk2(v[j].x, v[j].y) | ((unsigned long long)pk2(v[j].z, v[j].w) << 32);
        const f32x4 pv = ((const GAS f32x4*)(F.p + (size_t)m * PLE))[F.lane];
        ((GAS unsigned long long*)((bf16*)(ws + WS_PB) + (size_t)m * PLE))[F.lane] = (unsigned long long)pk2(pv.x, pv.y) | ((unsigned long long)pk2(pv.z, pv.w) << 32);
    }
    { const int gt = gw * 64 + F.lane, NT = NGW * 64;
      for (int idx = gt; idx < M * 16; idx += NT) { const int m = idx >> 4, i = idx & 15;
        const float invf = exp2f(-(float)(2 * i) * (13.287712379549449f / 32.f));
        const float ang = (float)F.pos[m] * invf;
        double rev = (double)ang * 0.15915494309189535; rev -= rint(rev);
        const float rv = (float)rev;
        float2 cs; cs.x = __builtin_amdgcn_cosf(rv); cs.y = __builtin_amdgcn_sinf(rv);
        ((float2*)(ws + WS_ROPE))[idx] = cs; } }
}

__device__ __forceinline__ void naive_prep(Frame& F) {
    const int gw = F.vcu * NWAVES + F.wave, NGW = F.G * NWAVES, lane = F.lane;
    float* cqs = (float*)(F.ldsg + F.wave * 12288);
    float* ckvs = cqs + 8 * 256;
    const bf16* z = (const bf16*)(F.ws + WS_Z);
    bf16* Q = (bf16*)(F.ws + WS_Q); bf16* K = (bf16*)(F.ws + WS_K); bf16* V = (bf16*)(F.ws + WS_V);
    const float2* rope = (const float2*)(F.ws + WS_ROPE);
    for (int rg = gw; rg < M / 8; rg += NGW) {
        float krv[8];
#pragma unroll
        for (int r = 0; r < 8; ++r) { const int row = rg * 8 + r; const bf16* zr = z + (size_t)row * ZW;
            float c[4]; float ss = 0.f;
#pragma unroll
            for (int j = 0; j < 4; ++j) { c[j] = bf2f(zr[Z_CQ + lane * 4 + j]); ss += c[j] * c[j]; }
            ss = wave_sum(ss); const float rq = 1.0f / sqrtf(ss * (1.f / 256.f) + EPS);
#pragma unroll
            for (int j = 0; j < 4; ++j) cqs[r * 256 + lane * 4 + j] = c[j] * rq * F.qn[lane * 4 + j];
            float d0 = bf2f(zr[Z_CKV + lane * 2]), d1 = bf2f(zr[Z_CKV + lane * 2 + 1]);
            float s2 = wave_sum(d0 * d0 + d1 * d1); const float rkv = 1.0f / sqrtf(s2 * (1.f / 128.f) + EPS);
            ckvs[r * 128 + lane * 2] = d0 * rkv * F.kvn[lane * 2]; ckvs[r * 128 + lane * 2 + 1] = d1 * rkv * F.kvn[lane * 2 + 1];
            krv[r] = lane < 32 ? bf2f(zr[Z_KR + lane]) : 0.f; }
        __builtin_amdgcn_s_waitcnt(0); asm volatile("" ::: "memory");
        for (int h = 0; h < MH; ++h) {
            float a0[8], a1[8];
#pragma unroll
            for (int r = 0; r < 8; ++r) { a0[r] = 0.f; a1[r] = 0.f; }
            const int n0 = h * 96 + lane, n1 = h * 96 + 64 + (lane & 31);
            for (int k = 0; k < 256; ++k) { const float w0 = F.wuq[(size_t)k * 768 + n0], w1 = F.wuq[(size_t)k * 768 + n1];
#pragma unroll
                for (int r = 0; r < 8; ++r) { const float a = cqs[r * 256 + k]; a0[r] += a * w0; a1[r] += a * w1; } }
#pragma unroll
            for (int r = 0; r < 8; ++r) { const int row = rg * 8 + r, b = row / SEQ, s = row % SEQ;
                const float ss = wave_sum(a0[r] * a0[r] + (lane < 32 ? a1[r] * a1[r] : 0.f)); const float rq = 1.0f / sqrtf(ss * (1.f / 96.f) + EPS);
                const float v0 = a0[r] * rq * F.nq[lane]; const float v1 = a1[r] * rq * F.nq[64 + (lane & 31)];
                const float pr = __shfl_xor(v1, 16); const float2 cs = rope[row * 16 + (lane & 15)];
                const float o1 = ((lane & 31) < 16) ? v1 * cs.x - pr * cs.y : v1 * cs.x + pr * cs.y;
                bf16* qp = Q + ((size_t)(b * MH + h) * SEQ + s) * QKD;
                qp[lane] = (bf16)f2bf(v0 * QSCALE); if (lane < 32) qp[64 + lane] = (bf16)f2bf(o1 * QSCALE); }
#pragma unroll
            for (int r = 0; r < 8; ++r) { a0[r] = 0.f; a1[r] = 0.f; }
            const int m0 = h * 128 + lane, m1 = h * 128 + 64 + lane;
            for (int k = 0; k < 128; ++k) { const float w0 = F.wukv[(size_t)k * 1024 + m0], w1 = F.wukv[(size_t)k * 1024 + m1];
#pragma unroll
                for (int r = 0; r < 8; ++r) { const float a = ckvs[r * 128 + k]; a0[r] += a * w0; a1[r] += a * w1; } }
#pragma unroll
            for (int r = 0; r < 8; ++r) { const int row = rg * 8 + r, b = row / SEQ, s = row % SEQ;
                const float ss = wave_sum(a0[r] * a0[r] + krv[r] * krv[r]); const float rk = 1.0f / sqrtf(ss * (1.f / 96.f) + EPS);
                const float v0 = a0[r] * rk * F.nk[lane]; const float xr = krv[r] * rk * F.nk[64 + (lane & 31)];
                const float pr = __shfl_xor(xr, 16); const float2 cs = rope[row * 16 + (lane & 15)];
                const float o1 = ((lane & 31) < 16) ? xr * cs.x - pr * cs.y : xr * cs.x + pr * cs.y;
                bf16* kp = K + ((size_t)(b * MH + h) * SEQ + s) * QKD;
                kp[lane] = (bf16)f2bf(v0); if (lane < 32) kp[64 + lane] = (bf16)f2bf(o1);
                V[((size_t)(b * MH + h) * SEQ + s) * VD + lane] = (bf16)f2bf(a1[r]); }
        }
        __builtin_amdgcn_s_waitcnt(0); asm volatile("" ::: "memory");
    }
}
__device__ __forceinline__ void naive_attn(Frame& F) {
    const bf16* Q = (const bf16*)(F.ws + WS_Q); const bf16* K = (const bf16*)(F.ws + WS_K); const bf16* V = (const bf16*)(F.ws + WS_V);
    bf16* mix = (bf16*)(F.ws + WS_MIX);
    const int qrow = F.tid >> 3, sub = F.tid & 7;
    for (int it = blockIdx.x; it < 128 * 32; it += F.G) {
        const int bh = it & 127, c = it >> 7, b = bh >> 3, h = bh & 7, s = 64 * c + qrow;
        float q[96], o[64];
        { const v4u* qp = (const v4u*)(Q + ((size_t)bh * SEQ + s) * QKD);
#pragma unroll
          for (int j = 0; j < 12; ++j) { const v4u w = qp[j]; q[8 * j] = bflo(w.x); q[8 * j + 1] = bfhi(w.x); q[8 * j + 2] = bflo(w.y); q[8 * j + 3] = bfhi(w.y); q[8 * j + 4] = bflo(w.z); q[8 * j + 5] = bfhi(w.z); q[8 * j + 6] = bflo(w.w); q[8 * j + 7] = bfhi(w.w); } }
#pragma unroll
        for (int d = 0; d < 64; ++d) o[d] = 0.f;
        float mx = -INFINITY, l = 0.f;
        const int nk = 64 * (c + 1);
        for (int j = sub; j < nk; j += 8) {
            const v4u* kp = (const v4u*)(K + ((size_t)bh * SEQ + j) * QKD); float sc = 0.f;
#pragma unroll
            for (int t = 0; t < 12; ++t) { const v4u w = kp[t]; sc += q[8 * t] * bflo(w.x) + q[8 * t + 1] * bfhi(w.x) + q[8 * t + 2] * bflo(w.y) + q[8 * t + 3] * bfhi(w.y) + q[8 * t + 4] * bflo(w.z) + q[8 * t + 5] * bfhi(w.z) + q[8 * t + 6] * bflo(w.w) + q[8 * t + 7] * bfhi(w.w); }
            const float mn = fmaxf(mx, sc), f = exp2f(mx - mn), pr = exp2f(sc - mn); mx = mn; l = l * f + pr;
            const v4u* vp = (const v4u*)(V + ((size_t)bh * SEQ + j) * VD);
#pragma unroll
            for (int t = 0; t < 8; ++t) { const v4u w = vp[t];
                o[8 * t] = o[8 * t] * f + pr * bflo(w.x); o[8 * t + 1] = o[8 * t + 1] * f + pr * bfhi(w.x); o[8 * t + 2] = o[8 * t + 2] * f + pr * bflo(w.y); o[8 * t + 3] = o[8 * t + 3] * f + pr * bfhi(w.y);
                o[8 * t + 4] = o[8 * t + 4] * f + pr * bflo(w.z); o[8 * t + 5] = o[8 * t + 5] * f + pr * bfhi(w.z); o[8 * t + 6] = o[8 * t + 6] * f + pr * bflo(w.w); o[8 * t + 7] = o[8 * t + 7] * f + pr * bfhi(w.w); }
        }
        float ma = mx; ma = fmaxf(ma, __shfl_xor(ma, 1)); ma = fmaxf(ma, __shfl_xor(ma, 2)); ma = fmaxf(ma, __shfl_xor(ma, 4));
        const float f = exp2f(mx - ma); l *= f; l += __shfl_xor(l, 1); l += __shfl_xor(l, 2); l += __shfl_xor(l, 4);
        const float il = 1.0f / l;
#pragma unroll
        for (int d = 0; d < 64; ++d) { float v = o[d] * f; v += __shfl_xor(v, 1); v += __shfl_xor(v, 2); v += __shfl_xor(v, 4); o[d] = v * il; }
        if (sub == 0) { v4u* op = (v4u*)(mix + (size_t)(b * SEQ + s) * DM + 512 + h * VD);
#pragma unroll
            for (int t = 0; t < 8; ++t) { v4u w; w.x = pk2(o[8 * t], o[8 * t + 1]); w.y = pk2(o[8 * t + 2], o[8 * t + 3]); w.z = pk2(o[8 * t + 4], o[8 * t + 5]); w.w = pk2(o[8 * t + 6], o[8 * t + 7]); op[t] = w; } }
    }
}
__device__ __forceinline__ void naive_gla(Frame& F) {
    float* as = (float*)F.ldsg; float* qs = as + 4096; float* ks = qs + 4096; float* vs = ks + 4096; float* os = vs + 8192; float* w2s = os + 8192; float* bs = w2s + 1024;
    const bf16* z = (const bf16*)(F.ws + WS_Z); bf16* mix = (bf16*)(F.ws + WS_MIX);
    const int tid = F.tid, j = tid >> 2, kq = tid & 3, t8 = tid >> 3, g8 = tid & 7;
    for (int bh = blockIdx.x; bh < BATCH * 4; bh += F.G) {
        const int b = bh >> 2, h = bh & 3;
        for (int i = tid; i < 1024; i += 512) w2s[i] = F.w2[(i >> 6) * 256 + h * 64 + (i & 63)];
        if (tid < 64) bs[tid] = F.gb[h * 64 + tid];
        float st[16];
#pragma unroll
        for (int i = 0; i < 16; ++i) st[i] = 0.f;
        __syncthreads();
        for (int c = 0; c < 32; ++c) {
            const int row0 = b * SEQ + 64 * c;
            { const bf16* zr = z + (size_t)(row0 + t8) * ZW; float g[16];
#pragma unroll
              for (int r = 0; r < 16; ++r) g[r] = bf2f(zr[Z_GL + r]);
#pragma unroll
              for (int i = 0; i < 8; ++i) { const int k = g8 * 8 + i; float y = bs[k];
#pragma unroll
                  for (int r = 0; r < 16; ++r) y += g[r] * w2s[r * 64 + k];
                  as[t8 * 64 + k] = __expf(logsigmoidf(y) * (1.f / 16.f)); qs[t8 * 64 + k] = bf2f(zr[Z_GQ + h * 64 + k]) * 0.125f; ks[t8 * 64 + k] = bf2f(zr[Z_GK + h * 64 + k]); }
#pragma unroll
              for (int i = 0; i < 16; ++i) vs[t8 * 128 + g8 * 16 + i] = bf2f(zr[Z_GV + h * 128 + g8 * 16 + i]); }
            __syncthreads();
            for (int t = 0; t < 64; ++t) { const float vj = vs[t * 128 + j]; float o = 0.f;
#pragma unroll
                for (int i = 0; i < 16; ++i) { const int kk = kq * 16 + i; st[i] = as[t * 64 + kk] * st[i] + ks[t * 64 + kk] * vj; o += qs[t * 64 + kk] * st[i]; }
                o += __shfl_xor(o, 1); o += __shfl_xor(o, 2); if (kq == 0) os[t * 128 + j] = o; }
            __syncthreads();
            { float ss = 0.f;
#pragma unroll
              for (int i = 0; i < 16; ++i) { const float v = os[t8 * 128 + g8 * 16 + i]; ss += v * v; }
              ss += __shfl_xor(ss, 1); ss += __shfl_xor(ss, 2); ss += __shfl_xor(ss, 4);
              const float r = 1.0f / sqrtf(ss * (1.f / 128.f) + EPS); const bf16* zr = z + (size_t)(row0 + t8) * ZW;
#pragma unroll
              for (int i = 0; i < 16; ++i) { const int jj = g8 * 16 + i; const float gr = bf2f(zr[Z_GR + h * 128 + jj]); const float sl = gr / (1.f + __expf(-gr));
                  mix[(size_t)(row0 + t8) * DM + h * 128 + jj] = (bf16)f2bf(os[t8 * 128 + jj] * r * F.gon[jj] * sl); } }
            __syncthreads();
        }
    }
}

struct Args { const void* in[22]; float* out; unsigned char* ws; int ph_lo, ph_hi, li, pad; };
__global__ void __launch_bounds__(NWAVES * 64, 2) fwd(Args args) {
    extern __shared__ __attribute__((aligned(16))) unsigned char lds[];
    Frame F;
    F.lds = (LAS unsigned char*)lds; F.ldsg = lds;
    F.MISC = (volatile LAS unsigned*)(F.lds + MISC_OFF);
    F.tid = threadIdx.x; F.lane = F.tid & 63; F.wave = __builtin_amdgcn_readfirstlane(F.tid >> 6);
    F.G = gridDim.x; { const int bx = blockIdx.x; F.vcu = (F.G % 8 == 0) ? (bx % 8) * (F.G / 8) + bx / 8 : bx; }
    unsigned char* ws = args.ws; F.ws = ws;
    F.ctl = (gu32*)(ws + WS_CTL);
    F.x = (const float*)args.in[0]; F.p = (const float*)args.in[1]; F.pos = (const int*)args.in[2]; F.attn_norm = (const float*)args.in[3]; F.w_in = (const float*)args.in[4];
    F.w2 = (const float*)args.in[5]; F.gb = (const float*)args.in[6]; F.gon = (const float*)args.in[7]; F.qn = (const float*)args.in[8]; F.wuq = (const float*)args.in[9];
    F.kvn = (const float*)args.in[10]; F.wukv = (const float*)args.in[11]; F.nq = (const float*)args.in[12]; F.nk = (const float*)args.in[13]; F.w_out = (const float*)args.in[14];
    F.mlp_norm = (const float*)args.in[15]; F.w_up = (const float*)args.in[16]; F.w_dn = (const float*)args.in[17]; F.ple_norm = (const float*)args.in[18]; F.w_g = (const float*)args.in[19];
    F.b_g = (const float*)args.in[20]; F.w_p = (const float*)args.in[21]; F.out = args.out;
    for (int u = F.tid; u < (LDS_BYTES - LDSCTL_OFF) / 4; u += NWAVES * 64) ((LAS unsigned*)(F.lds + LDSCTL_OFF))[u] = 0u;
    __syncthreads();
    XcdBarrier bar; bar.bar = (unsigned*)(F.ctl + CW_BAR); bar.x = 0; bar.st = nullptr;
    if (N_LAUNCHES != NPH) bar = xcd_barrier_post((unsigned*)(F.ctl + CW_BAR), F.MISC + 8);
#define GRID_BAR(seam) do { if (N_LAUNCHES == NPH) { if (F.tid == 0) __hip_atomic_store(F.ctl + CW_TMO, 0xBADBA0u | (unsigned)(seam), RLX_AGENT); } else { xcd_barrier(bar); } } while (0)
    const int lo = args.ph_lo, hi = args.ph_hi;
#define IN(k) (lo <= (k) && (k) < hi)
#define BOTH(k) (IN(k) && IN((k) + 1))
    bf16* XB = (bf16*)(ws + WS_XB); bf16* Z = (bf16*)(ws + WS_Z); bf16* MIX = (bf16*)(ws + WS_MIX); bf16* H1B = (bf16*)(ws + WS_H1B); bf16* H2B = (bf16*)(ws + WS_H2B);
    bf16* HID = (bf16*)(ws + WS_HID); bf16* PB = (bf16*)(ws + WS_PB); bf16* PP = (bf16*)(ws + WS_PP);
    float* SSQ2 = (float*)(ws + WS_CTL + CTL_SSQ2); float* SSQ3 = (float*)(ws + WS_CTL + CTL_SSQ3);

    if (IN(0)) { p0_prologue(F); if (BOTH(0)) GRID_BAR(0); }
    if (IN(1)) {
        pg8::Gemm g{XB, (const bf16*)(ws + WS_WIN), M, ZW, DM}; pg8::StaticOrder S; S.init(M, ZW, F.G, (int)blockIdx.x);
        pg8::EpiBf<0> E{Z, ZW, (const float*)(ws + WS_RS1)};
        pg8::gemm_phase<pg8::EpiBf<0>, pg8::StaticOrder, true, true>(F.lds + RING_OFF, g, S, E);
        if (BOTH(1)) GRID_BAR(1);
    }
    if (IN(2)) {
        naive_prep(F);
        if (BOTH(2)) GRID_BAR(2);
    }
    if (IN(3)) {
        naive_attn(F);
        if (BOTH(3)) GRID_BAR(3);
    }
    if (IN(4)) {
        naive_gla(F);
        if (BOTH(4)) GRID_BAR(4);
    }
    if (IN(5)) {
        { pg8::Gemm g{MIX, (const bf16*)(ws + WS_WOUT), M, DM, DM}; pg8::StaticOrder S; S.init(M, DM, F.G, (int)blockIdx.x);
          pg8::EpiRes E{F.x, F.out, H1B, SSQ2, DM};
          pg8::gemm_phase<pg8::EpiRes, pg8::StaticOrder, true, true>(F.lds + RING_OFF, g, S, E); }
        { pg8::Gemm g{PB, (const bf16*)(ws + WS_WP), M, DM, PLE}; pg8::StaticOrder S; S.init(M, DM, F.G, (int)blockIdx.x);
          pg8::EpiBf<2> E{PP, DM, nullptr};
          pg8::gemm_phase<pg8::EpiBf<2>, pg8::StaticOrder, true, true>(F.lds + RING_OFF, g, S, E); }
        if (BOTH(5)) GRID_BAR(5);
    }
    if (IN(6)) {
        pg8::Gemm g{H1B, (const bf16*)(ws + WS_WUP), M, FF, DM}; pg8::StaticOrder S; S.init(M, FF, F.G, (int)blockIdx.x);
        pg8::EpiBf<1> E{HID, FF, SSQ2};
        pg8::gemm_phase<pg8::EpiBf<1>, pg8::StaticOrder, true, true>(F.lds + RING_OFF, g, S, E);
        if (BOTH(6)) GRID_BAR(6);
    }
    if (IN(7)) {
        pg8::Gemm g{HID, (const bf16*)(ws + WS_WDN), M, DM, FF}; pg8::StaticOrder S; S.init(M, DM, F.G, (int)blockIdx.x);
        pg8::EpiRes E{F.out, F.out, H2B, SSQ3, DM};
        pg8::gemm_phase<pg8::EpiRes, pg8::StaticOrder, true, true>(F.lds + RING_OFF, g, S, E);
        if (BOTH(7)) GRID_BAR(7);
    }
    if (IN(8)) {
        pg8::Gemm g{H2B, (const bf16*)(ws + WS_WG), M, DM, DM}; pg8::StaticOrder S; S.init(M, DM, F.G, (int)blockIdx.x);
        pg8::EpiGate E{SSQ3, F.b_g, PP, F.out, DM};
        pg8::gemm_phase<pg8::EpiGate, pg8::StaticOrder, true, true>(F.lds + RING_OFF, g, S, E);
    }
#undef IN
#undef BOTH
}

extern "C" void kernel_launch(void* const* d_in, const int* in_sizes, int n_in, void* d_out, int out_size, void* d_ws, size_t ws_size, hipStream_t stream) {
    static int grid = 0;
    if (grid == 0) {
        if (n_in != 22 || in_sizes[0] != M * DM || out_size != M * DM || ws_size < WS_END) { fprintf(stderr, "kernel_launch: unexpected shapes (n_in %d, in0 %d, out %d, ws %zu); nothing launched\n", n_in, n_in > 0 ? in_sizes[0] : -1, out_size, ws_size); grid = -1; return; }
        int dev = 0, cus = 0, per_cu = 0;
        if (hipGetDevice(&dev) != hipSuccess || hipDeviceGetAttribute(&cus, hipDeviceAttributeMultiprocessorCount, dev) != hipSuccess) { grid = -1; return; }
        if (hipFuncSetAttribute((const void*)fwd, hipFuncAttributeMaxDynamicSharedMemorySize, LDS_BYTES) != hipSuccess) { fprintf(stderr, "kernel_launch: hipFuncSetAttribute failed\n"); grid = -1; return; }
        if (hipOccupancyMaxActiveBlocksPerMultiprocessor(&per_cu, (const void*)fwd, NWAVES * 64, LDS_BYTES) != hipSuccess || per_cu < 1)
            fprintf(stderr, "kernel_launch: note: occupancy query reports %d workgroups per CU\n", per_cu);
        (void)hipGetLastError();
        grid = cus;
    }
    if (grid < 0) return;
    if (hipMemsetAsync((char*)d_ws + WS_CTL, 0, CTL_ZERO_BYTES, stream) != hipSuccess) { fprintf(stderr, "kernel_launch: hipMemsetAsync failed\n"); return; }
    Args a{};
    for (int i = 0; i < 22; ++i) a.in[i] = d_in[i];
    a.out = (float*)d_out; a.ws = (unsigned char*)d_ws;
    for (int li = 0; li < N_LAUNCHES; ++li) {
        a.ph_lo = (N_LAUNCHES == NPH) ? li : 0; a.ph_hi = (N_LAUNCHES == NPH) ? li + 1 : NPH; a.li = li;
        hipLaunchKernelGGL(fwd, dim3(grid), dim3(NWAVES * 64), LDS_BYTES, stream, a);
        const hipError_t le = hipPeekAtLastError();
        if (le != hipSuccess) { fprintf(stderr, "kernel_launch: launch %d failed: %s\n", li, hipGetErrorName(le)); break; }
    }
}
```

```cpp
#define MK_N_LAUNCHES 1
#include <hip/hip_runtime.h>
#include <cstdio>
#include <cstdint>
namespace pg8 {
#define PG8_LAS __attribute__((address_space(3)))
typedef unsigned short bf16_t;
typedef short bf16x8 __attribute__((ext_vector_type(8)));
typedef float f32x4 __attribute__((ext_vector_type(4)));
typedef unsigned u32x4 __attribute__((ext_vector_type(4)));
constexpr int BM = 256, BK = 64, HALF = 128, HTB = HALF * BK * 2  , STAGE_BYTES = 8 * HTB, NXCD = 8, WGM = 8;

__host__ __device__ __forceinline__ int lds_byte(int r, int c) { const int st = (r >> 4) * 2 + (c >> 5), rr = r & 15, cc = c & 31, ob = rr * 64 + cc * 2; return st * 1024 + (ob ^ (((ob >> 9) & 1) << 5)); }
__host__ __device__ __forceinline__ void stage_rc(int b, int& R, int& C) { const int st = b / 1024, sb = b % 1024, swz = sb ^ (((sb >> 9) & 1) << 5); R = (st >> 1) * 16 + swz / 64; C = (st & 1) * 32 + (swz % 64) / 2; }
__host__ __device__ __forceinline__ int perm32(int rho) { const int n = rho >> 4, i = rho & 15; return 8 * (i >> 2) + 4 * n + (i & 3); }

struct Unit { int pm, pn; };
struct Gemm { const bf16_t* A; const bf16_t* Bt; int M, N, K; };

struct StaticOrder {
    int nM, nN, nwg, G, c;
    __host__ __device__ void init(int M, int N, int G_, int c_) { nM = M / BM; nN = N / BM; nwg = nM * nN; G = G_; c = c_; }
    __host__ __device__ bool next(int i, Unit& u) const {
        const long L = (long)i * G + c; if (L >= nwg) return false;
        int wgid = (int)L; { const int q = nwg / NXCD, r = nwg % NXCD, xcd = wgid % NXCD, off = wgid / NXCD; wgid = (xcd < r ? xcd * (q + 1) : r * (q + 1) + (xcd - r) * q) + off; }
        const int nig = WGM * nN, gid = wgid / nig, fm = gid * WGM, gsz = (nM - fm) < WGM ? (nM - fm) : WGM;
        u.pm = fm + ((wgid % nig) % gsz); u.pn = (wgid % nig) / gsz; return true;
    }
    __device__ __forceinline__ void a_ready(const Unit&) const {}
    __device__ __forceinline__ void done(const Unit&) const {}
};

__device__ __forceinline__ unsigned cvt_pk_bf16(float lo, float hi) { unsigned r; asm volatile("v_cvt_pk_bf16_f32 %0, %1, %2" : "=v"(r) : "v"(lo), "v"(hi)); return r; }
typedef float f32x2 __attribute__((ext_vector_type(2)));
typedef unsigned u32x2 __attribute__((ext_vector_type(2)));
constexpr float RMS_EPS = 1e-6f;
template <int MODE> struct EpiBf {
    static constexpr bool PERM = true, AFTER_DRAIN = false;
    bf16_t* O; int ldc; const float* rs;
    unsigned char* latq; unsigned char* latkv;
    __device__ __forceinline__ void operator()(const f32x4 (&acc)[2][2][4][2], const Unit& u, int wr, int wc, int fr, int fq) const {
        const int row0 = u.pm * BM + wr * 64 + fr, col0 = u.pn * BM + wc * 64 + 8 * fq;
        bool fm[2] = {false, false}; size_t fstride = 0; unsigned char* fb[2] = {nullptr, nullptr};
        if (MODE == 0 && latq) { const int lc = 32 * (fq & 1) * 16;
            if (u.pn == 6) { fm[0] = fm[1] = true; fstride = 16 * 1024; fb[0] = latq + (4 * wc + (fq >> 1)) * 1024 + lc; fb[1] = latq + (4 * wc + 2 + (fq >> 1)) * 1024 + lc; }
            else if (u.pn == 7 && wc < 2) { fm[0] = fm[1] = true; fstride = 8 * 1024; fb[0] = latkv + (4 * wc + (fq >> 1)) * 1024 + lc; fb[1] = latkv + (4 * wc + 2 + (fq >> 1)) * 1024 + lc; } }
#pragma unroll
        for (int ai = 0; ai < 2; ++ai)
#pragma unroll
            for (int m = 0; m < 4; ++m) { const int row = row0 + ai * HALF + m * 16; unsigned char* rowp = (unsigned char*)(O + (size_t)row * ldc + col0);
                float s = 1.f; if (MODE == 0) s = rs[row]; if (MODE == 1) s = __builtin_amdgcn_rsqf(rs[row] * (1.f / 1024.f) + RMS_EPS);
                const size_t foff = (size_t)(row >> 5) * fstride + (size_t)(row & 31) * 16;
#pragma unroll
                for (int bj = 0; bj < 2; ++bj) { f32x4 v0 = acc[ai][bj][m][0] * s, v1 = acc[ai][bj][m][1] * s;
                    if (MODE == 1) {
#pragma unroll
                        for (int e = 0; e < 4; ++e) { const float a = fmaxf(v0[e], 0.f), b = fmaxf(v1[e], 0.f); v0[e] = a * a; v1[e] = b * b; } }
                    u32x4 w; w.x = cvt_pk_bf16(v0[0], v0[1]); w.y = cvt_pk_bf16(v0[2], v0[3]); w.z = cvt_pk_bf16(v1[0], v1[1]); w.w = cvt_pk_bf16(v1[2], v1[3]);
                    unsigned char* dst = (MODE == 0 && fm[bj]) ? fb[bj] + foff : rowp + bj * 32 * 2;
                    *(u32x4*)dst = w; } }
    }
};
struct EpiRes3 {
    static constexpr bool PERM = true, AFTER_DRAIN = false;
    const bf16_t* base; bf16_t* ob; float* ssq; int ldc;
    __device__ __forceinline__ void operator()(const f32x4 (&acc)[2][2][4][2], const Unit& u, int wr, int wc, int fr, int fq) const {
        const int col0 = u.pn * BM + wc * 64 + 8 * fq;
#pragma unroll
        for (int ai = 0; ai < 2; ++ai) {
            u32x4 bw[4][2];
#pragma unroll
            for (int m = 0; m < 4; ++m) { const size_t off = (size_t)(u.pm * BM + ai * HALF + wr * 64 + m * 16 + fr) * ldc + col0;
#pragma unroll
                for (int bj = 0; bj < 2; ++bj) bw[m][bj] = *(const u32x4*)(base + off + bj * 32); }
#pragma unroll
            for (int m = 0; m < 4; ++m) { const int row = u.pm * BM + ai * HALF + wr * 64 + m * 16 + fr; const size_t off = (size_t)row * ldc + col0; float q = 0.f;
#pragma unroll
                for (int bj = 0; bj < 2; ++bj) { const u32x4 w_ = bw[m][bj];
                    f32x4 h0, h1;
                    h0[0] = __uint_as_float(w_.x << 16) + acc[ai][bj][m][0][0]; h0[1] = __uint_as_float(w_.x & 0xffff0000u) + acc[ai][bj][m][0][1]; h0[2] = __uint_as_float(w_.y << 16) + acc[ai][bj][m][0][2]; h0[3] = __uint_as_float(w_.y & 0xffff0000u) + acc[ai][bj][m][0][3];
                    h1[0] = __uint_as_float(w_.z << 16) + acc[ai][bj][m][1][0]; h1[1] = __uint_as_float(w_.z & 0xffff0000u) + acc[ai][bj][m][1][1]; h1[2] = __uint_as_float(w_.w << 16) + acc[ai][bj][m][1][2]; h1[3] = __uint_as_float(w_.w & 0xffff0000u) + acc[ai][bj][m][1][3];
                    q += ((h0[0] * h0[0] + h0[1] * h0[1]) + (h0[2] * h0[2] + h0[3] * h0[3])) + ((h1[0] * h1[0] + h1[1] * h1[1]) + (h1[2] * h1[2] + h1[3] * h1[3]));
                    u32x4 w; w.x = cvt_pk_bf16(h0[0], h0[1]); w.y = cvt_pk_bf16(h0[2], h0[3]); w.z = cvt_pk_bf16(h1[0], h1[1]); w.w = cvt_pk_bf16(h1[2], h1[3]); *(u32x4*)(ob + off + bj * 32) = w; }
                q += __shfl_xor(q, 16); q += __shfl_xor(q, 32);
                if (fq == 0) atomicAdd(ssq + row, q); }
            asm volatile("" ::: "memory"); }
    }
};
struct EpiGate3 {
    static constexpr bool PERM = true, AFTER_DRAIN = false;
    const float* ssq; const float* bias; const bf16_t* pp; const bf16_t* hb; float* out; int ldc;
    __device__ __forceinline__ void operator()(const f32x4 (&acc)[2][2][4][2], const Unit& u, int wr, int wc, int fr, int fq) const {
        const int col0 = u.pn * BM + wc * 64 + 8 * fq;
        f32x4 bv[2][2];
#pragma unroll
        for (int bj = 0; bj < 2; ++bj)
#pragma unroll
            for (int n = 0; n < 2; ++n) bv[bj][n] = *(const f32x4*)(bias + col0 + bj * 32 + n * 4);
#pragma unroll
        for (int ai = 0; ai < 2; ++ai) {
            u32x4 hw[4][2], pw[4][2]; float sq[4];
#pragma unroll
            for (int m = 0; m < 4; ++m) { const int row = u.pm * BM + ai * HALF + wr * 64 + m * 16 + fr; const size_t off = (size_t)row * ldc + col0; sq[m] = ssq[row];
#pragma unroll
                for (int bj = 0; bj < 2; ++bj) { hw[m][bj] = *(const u32x4*)(hb + off + bj * 32); pw[m][bj] = *(const u32x4*)(pp + off + bj * 32); } }
#pragma unroll
            for (int m = 0; m < 4; ++m) { const int row = u.pm * BM + ai * HALF + wr * 64 + m * 16 + fr; const size_t off = (size_t)row * ldc + col0;
                const float s = __builtin_amdgcn_rsqf(sq[m] * (1.f / 1024.f) + RMS_EPS);
#pragma unroll
                for (int bj = 0; bj < 2; ++bj) { const u32x4 h_ = hw[m][bj], p_ = pw[m][bj];
                    const unsigned hh[4] = {h_.x, h_.y, h_.z, h_.w}, ph[4] = {p_.x, p_.y, p_.z, p_.w};
#pragma unroll
                    for (int n = 0; n < 2; ++n) { const f32x4 y = acc[ai][bj][m][n] * s + bv[bj][n]; f32x4 o;
                        const float hv[4] = {__uint_as_float(hh[2 * n] << 16), __uint_as_float(hh[2 * n] & 0xffff0000u), __uint_as_float(hh[2 * n + 1] << 16), __uint_as_float(hh[2 * n + 1] & 0xffff0000u)};
                        const float pf[4] = {__uint_as_float(ph[2 * n] << 16), __uint_as_float(ph[2 * n] & 0xffff0000u), __uint_as_float(ph[2 * n + 1] << 16), __uint_as_float(ph[2 * n + 1] & 0xffff0000u)};
#pragma unroll
                        for (int e = 0; e < 4; ++e) { const float g = __builtin_amdgcn_rcpf(1.f + __builtin_amdgcn_exp2f(-1.4426950408889634f * y[e])); o[e] = hv[e] + pf[e] * g; }
                        *(f32x4*)(out + off + bj * 32 + n * 4) = o; } } }
            asm volatile("" ::: "memory"); }
    }
};
template <class Epi, class Sched, bool ALIGN_EPI = false, bool SP2 = false>
__device__ __forceinline__ void gemm_phase(PG8_LAS unsigned char* lds, const Gemm g, const Sched& S, const Epi& E) {
    const int tid = threadIdx.x, wid = __builtin_amdgcn_readfirstlane(tid >> 6), lane = tid & 63, wr = wid >> 2, wc = wid & 3, fr = lane & 15, fq = lane >> 4;
    const int K = g.K, nt = K / BK;
    unsigned voffA[2], voffB[2];
#pragma unroll
    for (int i = 0; i < 2; ++i) { int R, C; stage_rc(tid * 16 + i * 8192, R, C); const int Rb = Epi::PERM ? (2 * (R & ~31) + perm32(R & 31)) : R;
        voffA[i] = (unsigned)(R * K + C) * 2u; voffB[i] = (unsigned)(Rb * K + C) * 2u; }
    const size_t kstep = (size_t)(BK * 2);
    const size_t hstep = (size_t)HALF * K * 2;
    const size_t tstep = 2 * hstep;
    const size_t hstepB = Epi::PERM ? (size_t)32 * K * 2 : hstep;
    const unsigned ldsw = (unsigned)wid * 1024u;
    const int aoff = lds_byte(wr * 64 + fr, fq * 8), boff = lds_byte(wc * 32 + fr, fq * 8);
#define PG8_SA(b, h) (((b) * 2 + (h)) * HTB)
#define PG8_SB(b, h) ((4 + (b) * 2 + (h)) * HTB)
#define PG8_STAGE(bufoff, gbase, voff) do { _Pragma("unroll") for (int _i = 0; _i < 2; ++_i) \
        __builtin_amdgcn_global_load_lds((const unsigned*)((const char*)(gbase) + (voff)[_i]), (PG8_LAS unsigned*)(lds + (bufoff) + ldsw + _i * 8192), 16, 0, 0); } while (0)
#define PG8_LDA(dst, b, h) do { _Pragma("unroll") for (int m = 0; m < 4; ++m) _Pragma("unroll") for (int k = 0; k < 2; ++k) dst[m][k] = *(const PG8_LAS bf16x8*)(lds + PG8_SA(b, h) + aoff + m * 2048 + k * 1024); } while (0)
#define PG8_LDB(dst, b, h) do { _Pragma("unroll") for (int n = 0; n < 2; ++n) _Pragma("unroll") for (int k = 0; k < 2; ++k) dst[n][k] = *(const PG8_LAS bf16x8*)(lds + PG8_SB(b, h) + boff + n * 2048 + k * 1024); } while (0)
#define PG8_MMA(ai, bj, At, Bt) do { __builtin_amdgcn_s_setprio(1); _Pragma("unroll") for (int m = 0; m < 4; ++m) _Pragma("unroll") for (int n = 0; n < 2; ++n) _Pragma("unroll") for (int k = 0; k < 2; ++k) \
        acc[ai][bj][m][n] = __builtin_amdgcn_mfma_f32_16x16x32_bf16(Bt[n][k], At[m][k], acc[ai][bj][m][n], 0, 0, 0); __builtin_amdgcn_s_setprio(0); } while (0)
#define PG8_WAIT_V(n) asm volatile("s_waitcnt vmcnt(" #n ")" ::: "memory")
#define PG8_WAIT_L(n) asm volatile("s_waitcnt lgkmcnt(" #n ")" ::: "memory")
#define PG8_BAR __builtin_amdgcn_s_barrier()
#define PG8_SCHED __builtin_amdgcn_sched_barrier(0)
    Unit cur, nxt; int ui = 0;
    if (!S.next(0, cur)) return;
    f32x4 acc[2][2][4][2];
#pragma unroll
    for (int a = 0; a < 2; ++a)
#pragma unroll
        for (int b = 0; b < 2; ++b)
#pragma unroll
            for (int m = 0; m < 4; ++m)
#pragma unroll
                for (int n = 0; n < 2; ++n) acc[a][b][m][n] = (f32x4){0.f, 0.f, 0.f, 0.f};
    bf16x8 At[4][2], B0[2][2], B1[2][2];
    const char* cA = (const char*)g.A + (size_t)cur.pm * tstep; const char* cB = (const char*)g.Bt + (size_t)cur.pn * tstep;
    S.a_ready(cur);
    if constexpr (SP2) {
        PG8_STAGE(PG8_SB(0, 0), cB, voffB); PG8_STAGE(PG8_SB(0, 1), cB + hstepB, voffB); PG8_STAGE(PG8_SA(0, 0), cA, voffA); PG8_STAGE(PG8_SA(0, 1), cA + hstep, voffA);
        if (wr == 1) PG8_BAR;
        PG8_WAIT_V(2); PG8_BAR;
        PG8_STAGE(PG8_SB(1, 0), cB + kstep, voffB); PG8_STAGE(PG8_SA(1, 0), cA + kstep, voffA); PG8_STAGE(PG8_SB(1, 1), cB + hstepB + kstep, voffB);
        PG8_WAIT_V(6); PG8_BAR;
    } else {
        PG8_STAGE(PG8_SB(0, 0), cB, voffB); PG8_STAGE(PG8_SA(0, 0), cA, voffA); PG8_STAGE(PG8_SB(0, 1), cB + hstepB, voffB); PG8_STAGE(PG8_SA(0, 1), cA + hstep, voffA);
        if (wr == 1) PG8_BAR;
        PG8_WAIT_V(4); PG8_BAR;
        PG8_STAGE(PG8_SB(1, 0), cB + kstep, voffB); PG8_STAGE(PG8_SA(1, 0), cA + kstep, voffA); PG8_STAGE(PG8_SB(1, 1), cB + hstepB + kstep, voffB);
        PG8_WAIT_V(6); PG8_BAR;
    }
    for (;;) {
        const bool has_next = S.next(ui + 1, nxt);
        const char* nA = has_next ? (const char*)g.A + (size_t)nxt.pm * tstep : cA; const char* nB = has_next ? (const char*)g.Bt + (size_t)nxt.pn * tstep : cB;
        for (int t = 0; t < nt; t += 2) {
            const bool last = (t == nt - 2);
            const char* a1 = cA + (size_t)(t + 1) * kstep;
            const char* a2 = last ? nA : cA + (size_t)(t + 2) * kstep; const char* b2 = last ? nB : cB + (size_t)(t + 2) * kstep;
            const char* a3 = a2 + kstep; const char* b3 = b2 + kstep;
            if (last && has_next) S.a_ready(nxt);
            if constexpr (SP2) {
            PG8_LDB(B0, 0, 0); PG8_LDB(B1, 0, 1); PG8_SCHED; PG8_LDA(At, 0, 0); PG8_STAGE(PG8_SA(1, 1), a1 + hstep, voffA);
            PG8_WAIT_V(8); PG8_WAIT_L(0); PG8_BAR; PG8_MMA(0, 0, At, B0); PG8_MMA(0, 1, At, B1); PG8_BAR; PG8_SCHED;
            PG8_LDA(At, 0, 1); PG8_STAGE(PG8_SB(0, 0), b2, voffB); PG8_STAGE(PG8_SB(0, 1), b2 + hstepB, voffB); PG8_STAGE(PG8_SA(0, 0), a2, voffA);
            PG8_WAIT_V(8); PG8_WAIT_L(0); PG8_BAR; PG8_MMA(1, 0, At, B0); PG8_MMA(1, 1, At, B1); PG8_BAR; PG8_SCHED;
            PG8_LDB(B0, 1, 0); PG8_LDB(B1, 1, 1); PG8_SCHED; PG8_LDA(At, 1, 0); PG8_STAGE(PG8_SA(0, 1), a2 + hstep, voffA);
            PG8_WAIT_V(8); PG8_WAIT_L(0); PG8_BAR; PG8_MMA(0, 0, At, B0); PG8_MMA(0, 1, At, B1); PG8_BAR; PG8_SCHED;
            PG8_LDA(At, 1, 1); PG8_STAGE(PG8_SB(1, 0), b3, voffB); PG8_STAGE(PG8_SB(1, 1), b3 + hstepB, voffB); PG8_STAGE(PG8_SA(1, 0), a3, voffA);
            PG8_WAIT_V(8); PG8_WAIT_L(0); PG8_BAR; PG8_MMA(1, 0, At, B0); PG8_MMA(1, 1, At, B1); PG8_BAR; PG8_SCHED;
            } else {
            PG8_LDB(B0, 0, 0); PG8_SCHED; PG8_LDA(At, 0, 0); PG8_STAGE(PG8_SA(1, 1), a1 + hstep, voffA);
            PG8_WAIT_L(8); PG8_BAR; PG8_WAIT_L(0); PG8_MMA(0, 0, At, B0); PG8_BAR; PG8_SCHED;
            PG8_LDB(B1, 0, 1); PG8_STAGE(PG8_SB(0, 0), b2, voffB);
            PG8_BAR; PG8_WAIT_L(0); PG8_MMA(0, 1, At, B1); PG8_BAR;
            PG8_LDA(At, 0, 1); PG8_STAGE(PG8_SA(0, 0), a2, voffA);
            PG8_BAR; PG8_WAIT_L(0); PG8_MMA(1, 0, At, B0); PG8_BAR; PG8_SCHED;
            PG8_STAGE(PG8_SB(0, 1), b2 + hstepB, voffB);
            PG8_WAIT_V(6); PG8_BAR; PG8_MMA(1, 1, At, B1); PG8_BAR;
            PG8_LDB(B0, 1, 0); PG8_SCHED; PG8_LDA(At, 1, 0); PG8_STAGE(PG8_SA(0, 1), a2 + hstep, voffA);
            PG8_WAIT_L(8); PG8_BAR; PG8_WAIT_L(0); PG8_MMA(0, 0, At, B0); PG8_BAR; PG8_SCHED;
            PG8_LDB(B1, 1, 1); PG8_STAGE(PG8_SB(1, 0), b3, voffB);
            PG8_BAR; PG8_WAIT_L(0); PG8_MMA(0, 1, At, B1); PG8_BAR;
            PG8_LDA(At, 1, 1); PG8_STAGE(PG8_SA(1, 0), a3, voffA);
            PG8_BAR; PG8_WAIT_L(0); PG8_MMA(1, 0, At, B0); PG8_BAR; PG8_SCHED;
            PG8_STAGE(PG8_SB(1, 1), b3 + hstepB, voffB);
            PG8_WAIT_V(6); PG8_BAR; PG8_MMA(1, 1, At, B1); PG8_BAR;
            }
        }
        if constexpr (ALIGN_EPI) { if (wr == 0) PG8_BAR; }
        if constexpr (!Epi::AFTER_DRAIN) { E(acc, cur, wr, wc, fr, fq); S.done(cur); }
        if (!has_next) break;
#pragma unroll
        for (int a = 0; a < 2; ++a)
#pragma unroll
            for (int b = 0; b < 2; ++b)
#pragma unroll
                for (int m = 0; m < 4; ++m)
#pragma unroll
                    for (int n = 0; n < 2; ++n) acc[a][b][m][n] = (f32x4){0.f, 0.f, 0.f, 0.f};
        cur = nxt; cA = nA; cB = nB; ++ui;
        if constexpr (ALIGN_EPI) { if (wr == 1) PG8_BAR; }
    }
    PG8_WAIT_V(0);
    if constexpr (!ALIGN_EPI) { if (wr == 0) PG8_BAR; }
    PG8_BAR;
    if constexpr (Epi::AFTER_DRAIN) { E.fused(acc, cur, wr, wc, fr, fq, lds, wid, lane); S.done(cur); }
#undef PG8_SA
#undef PG8_SB
#undef PG8_STAGE
#undef PG8_LDA
#undef PG8_LDB
#undef PG8_MMA
#undef PG8_WAIT_V
#undef PG8_WAIT_L
#undef PG8_BAR
#undef PG8_SCHED
}
}
constexpr int NWAVES = 8;
#ifndef MK_N_LAUNCHES
#define MK_N_LAUNCHES 1
#endif
constexpr int NPH = 9;
constexpr int N_LAUNCHES = MK_N_LAUNCHES;
constexpr int BATCH = 16, SEQ = 2048, DM = 1024, M = BATCH * SEQ, FF = 4096, PLE = 256, ZN = 2048, ZW = 2112;
constexpr int Z_GQ = 0, Z_GK = 256, Z_GV = 512, Z_GR = 1024, Z_CQ = 1536, Z_CKV = 1792, Z_KR = 1920, Z_GL = 1952;
constexpr int MH = 8, QKD = 96, VD = 64;
constexpr float EPS = 1e-6f;
constexpr float QSCALE = 0.10206207261596577f * 1.4426950408889634f;
constexpr size_t MiB = 1u << 20;
constexpr size_t WS_CTL = 0, CTL_ZERO_BYTES = 1 * MiB;
constexpr size_t CTL_SSQ2 = 256 * 1024, CTL_SSQ3 = 512 * 1024;
constexpr size_t WS_RS1 = 1 * MiB;
constexpr size_t WS_ROPE = 2 * MiB;
constexpr size_t WS_DEC = 6 * MiB;
constexpr size_t WS_WIN = 8 * MiB, WS_WOUT = 12 * MiB, WS_WUP = 14 * MiB, WS_WDN = 22 * MiB, WS_WG = 30 * MiB, WS_WP = 32 * MiB, WS_WUQ = 33 * MiB, WS_WUKV = 34 * MiB;
constexpr size_t WS_PB = 36 * MiB;
constexpr size_t WS_US = 52 * MiB;
constexpr size_t WS_Q = 84 * MiB, WS_K = 132 * MiB, WS_V = 180 * MiB;
constexpr size_t WS_PP = 52 * MiB;
constexpr size_t WS_H1B = 116 * MiB;
constexpr size_t WS_H2B = 180 * MiB;
constexpr size_t WS_LATQ = 212 * MiB, WS_LATKV = 228 * MiB;
constexpr size_t WS_XB = 244 * MiB;
constexpr size_t OUT_QED = 0 * MiB, OUT_KED = 16 * MiB, OUT_VTD = 32 * MiB;
constexpr size_t WS_Z = 308 * MiB;
constexpr size_t WS_MIX = 440 * MiB;
constexpr size_t WS_HID = 244 * MiB;
constexpr size_t WS_END = 504 * MiB;
static_assert(WS_Z + (size_t)M * ZW * 2 <= WS_MIX, "z fits");
constexpr int CW_TMO = 0, CW_CODE = 1, CW_BAR = 4096;
constexpr int RING_OFF = 0, RING_BYTES = 131072;
constexpr int LDSCTL_OFF = RING_BYTES, MISC_OFF = LDSCTL_OFF + 320;
constexpr int LDS_BYTES = 147456;
static_assert(MISC_OFF + 128 <= LDS_BYTES, "LDS map");
#define GAS __attribute__((address_space(1)))
#define LAS __attribute__((address_space(3)))
typedef unsigned short bf16;
typedef unsigned v4u __attribute__((ext_vector_type(4)));
typedef float f32x4 __attribute__((ext_vector_type(4)));
typedef short bf16x8 __attribute__((ext_vector_type(8)));
typedef GAS unsigned gu32;
typedef GAS unsigned long long gu64;
#define RLX_AGENT __ATOMIC_RELAXED, __HIP_MEMORY_SCOPE_AGENT
#define LDS_WAIT() asm volatile("s_waitcnt lgkmcnt(0)" ::: "memory")
#define VM_WAIT() asm volatile("s_waitcnt vmcnt(0)" ::: "memory")
__device__ __forceinline__ unsigned long long rt() { return __builtin_amdgcn_s_memrealtime(); }
__device__ __forceinline__ unsigned f2bf(float f) { unsigned u = __builtin_bit_cast(unsigned, f); return (u + 0x7fffu + ((u >> 16) & 1u)) >> 16; }
__device__ __forceinline__ unsigned pk2(float lo, float hi) { return f2bf(lo) | (f2bf(hi) << 16); }

#define XB_TMO      128
#define XB_XCNT(j)  (256  + 64 * (j))
#define XB_XSUB(j)  (1280 + 64 * (j))
#define XB_XGEN(j)  (2304 + 64 * (j))
#define XB_TOP      3328
#define XB_TOPGEN   3392
#define XCD_BAR_WORDS 3456
#define XB_SPIN_CAP (1u << 18)

__device__ __forceinline__ unsigned xb_ld(unsigned* p)              { return __hip_atomic_load(p, __ATOMIC_RELAXED, __HIP_MEMORY_SCOPE_AGENT); }
__device__ __forceinline__ unsigned xb_add(unsigned* p, unsigned v) { return __hip_atomic_fetch_add(p, v, __ATOMIC_RELAXED, __HIP_MEMORY_SCOPE_AGENT); }
__device__ __forceinline__ unsigned xb_xcc_id() { return (unsigned)__builtin_amdgcn_s_getreg((3 << 11) | 20) & 0xFu; }
#define XB_SPIN(cond, bar) do { unsigned _sp = 0; while (cond) { __builtin_amdgcn_s_sleep(1); \
    if ((++_sp & 255u) == 0u) { if (xb_ld(&(bar)[XB_TMO])) break; if (_sp > XB_SPIN_CAP) { atomicAdd(&(bar)[XB_TMO], 1u); break; } } } } while (0)

struct XcdBarrier {
    unsigned* bar; unsigned x;
    volatile LAS unsigned* st;
};

__device__ __forceinline__ XcdBarrier xcd_barrier_post(unsigned* bar, volatile LAS unsigned* st) {
    XcdBarrier b; b.bar = bar; b.x = xb_xcc_id(); b.st = st;
    if (threadIdx.x == 0) (void)xb_add(&bar[XB_XCNT(b.x)], 1u);
    return b;
}
__device__ __forceinline__ void xcd_barrier_complete(unsigned* bar, unsigned x, unsigned& nloc, unsigned& nx) {
    const unsigned G = gridDim.x * gridDim.y * gridDim.z;
    unsigned sum, cnt, mine, sp = 0u;
    for (;;) {
        sum = 0u; cnt = 0u; mine = 0u;
#pragma unroll
        for (unsigned j = 0; j < 16; ++j) { const unsigned c = xb_ld(&bar[XB_XCNT(j)]); sum += c; cnt += (c > 0u) ? 1u : 0u; mine = (j == x) ? c : mine; }
        if (sum == G) break;
        __builtin_amdgcn_s_sleep(1);
        if ((++sp & 255u) == 0u) { if (xb_ld(&bar[XB_TMO])) break; if (sp > XB_SPIN_CAP) { atomicAdd(&bar[XB_TMO], 1u); break; } }
    }
    nloc = mine > 0u ? mine : 1u; nx = cnt > 0u ? cnt : 1u;
}

__device__ __forceinline__ void xcd_barrier(const XcdBarrier& b) {
    asm volatile("s_waitcnt vmcnt(0)" ::: "memory");
    __syncthreads();
    if (threadIdx.x == 0) {
        unsigned* bar = b.bar;
        __builtin_amdgcn_s_waitcnt(0);
        unsigned nloc = b.st[0], nx = b.st[1];
        if (nloc == 0u) { xcd_barrier_complete(bar, b.x, nloc, nx); b.st[0] = nloc; b.st[1] = nx; }
        const unsigned old = xb_add(&bar[XB_XSUB(b.x)], 1u);
        const unsigned gen = old / nloc;
        if (old + 1u == (gen + 1u) * nloc) {
            __builtin_amdgcn_fence(__ATOMIC_RELEASE, "agent");
            asm volatile("s_waitcnt vmcnt(0)" ::: "memory");
            const unsigned og = xb_add(&bar[XB_TOP], 1u);
            const unsigned tg = og / nx;
            if (og + 1u == (tg + 1u) * nx) xb_add(&bar[XB_TOPGEN], 1u);
            else XB_SPIN(xb_ld(&bar[XB_TOPGEN]) == tg, bar);
            __builtin_amdgcn_fence(__ATOMIC_ACQUIRE, "agent");
            xb_add(&bar[XB_XGEN(b.x)], 1u);
            asm volatile("s_waitcnt vmcnt(0)" ::: "memory");
        } else {
            XB_SPIN(xb_ld(&bar[XB_XGEN(b.x)]) == gen, bar);
            __builtin_amdgcn_fence(__ATOMIC_ACQUIRE, "agent");
            asm volatile("s_waitcnt vmcnt(0)" ::: "memory");
        }
    }
    __syncthreads();
}
__device__ __forceinline__ float bf2f(bf16 h) { return __uint_as_float((unsigned)h << 16); }
namespace fa {
typedef float f32x16 __attribute__((ext_vector_type(16)));
typedef short s16x4 __attribute__((ext_vector_type(4)));
typedef unsigned u32x4 __attribute__((ext_vector_type(4)));
typedef float f32x2_t __attribute__((ext_vector_type(2))); typedef __bf16 bf16x2_t __attribute__((ext_vector_type(2)));
constexpr int KSLOT = 12288, VSLOT = 8192;
constexpr int NSLOT = 4;
constexpr int L_K = 0, L_V = NSLOT * KSLOT, L_WS = L_V + NSLOT * VSLOT, L_OST = L_WS + 8 * 256, L_END = L_OST + 8 * 4096;
static_assert(L_END <= 131072, "attention LDS");
__device__ __forceinline__ int crow(int r, int hi) { return (r & 3) + 8 * (r >> 2) + 4 * hi; }
__device__ __forceinline__ void glds16(const void* gsrc, unsigned lds_dst) { unsigned keep;
    asm volatile("s_mov_b32 %0, m0\n\ts_mov_b32 m0, %2\n\ts_nop 0\n\tglobal_load_lds_dwordx4 %1, off\n\ts_mov_b32 m0, %0" : "=&s"(keep) : "v"(gsrc), "s"(lds_dst) : "memory"); }
__device__ __forceinline__ unsigned cvtpk(float lo, float hi) { f32x2_t v = {lo, hi}; bf16x2_t b = __builtin_convertvector(v, bf16x2_t); return __builtin_bit_cast(unsigned, b); }
__device__ __forceinline__ void pv(f32x16* o, int vb, bf16x8 pa0, bf16x8 pa1, bf16x8 pa2, bf16x8 pa3) {
#pragma unroll
    for (int d0 = 0; d0 < 2; ++d0) { s16x4 lo[4], hi[4];
#pragma unroll
        for (int ks = 0; ks < 4; ++ks) {
            asm volatile("ds_read_b64_tr_b16 %0,%1 offset:%c2" : "=&v"(lo[ks]) : "v"(vb), "i"(d0 * 4096 + ks * 1024) : "memory");
            asm volatile("ds_read_b64_tr_b16 %0,%1 offset:%c2" : "=&v"(hi[ks]) : "v"(vb), "i"(d0 * 4096 + ks * 1024 + 512) : "memory"); }
        asm volatile("s_waitcnt lgkmcnt(0)" ::: "memory"); __builtin_amdgcn_sched_barrier(0);
#define FA_PK(k) (bf16x8){lo[k][0], lo[k][1], lo[k][2], lo[k][3], hi[k][0], hi[k][1], hi[k][2], hi[k][3]}
        o[d0] = __builtin_amdgcn_mfma_f32_32x32x16_bf16(pa0, FA_PK(0), o[d0], 0, 0, 0);
        o[d0] = __builtin_amdgcn_mfma_f32_32x32x16_bf16(pa1, FA_PK(1), o[d0], 0, 0, 0);
        o[d0] = __builtin_amdgcn_mfma_f32_32x32x16_bf16(pa2, FA_PK(2), o[d0], 0, 0, 0);
        o[d0] = __builtin_amdgcn_mfma_f32_32x32x16_bf16(pa3, FA_PK(3), o[d0], 0, 0, 0);
#undef FA_PK
    }
}
}
namespace prep {
typedef float f32x16 __attribute__((ext_vector_type(16)));
typedef unsigned u32x4 __attribute__((ext_vector_type(4)));
typedef unsigned u32x2 __attribute__((ext_vector_type(2)));
typedef float f32x2 __attribute__((ext_vector_type(2)));
__device__ __forceinline__ int crow(int r, int hi) { return (r & 3) + 8 * (r >> 2) + 4 * hi; }
__device__ __forceinline__ float hsum(float v) { auto rr = __builtin_amdgcn_permlane32_swap(__float_as_uint(v), __float_as_uint(v), false, false); return __uint_as_float(rr[0]) + __uint_as_float(rr[1]); }
}
#define LDS_BARRIER() do { asm volatile("s_waitcnt lgkmcnt(0)" ::: "memory"); __builtin_amdgcn_s_barrier(); asm volatile("" ::: "memory"); } while (0)
namespace gla {
typedef float f32x16 __attribute__((ext_vector_type(16)));
typedef unsigned u32x4 __attribute__((ext_vector_type(4)));
typedef unsigned u32x2 __attribute__((ext_vector_type(2)));
typedef short s16x4 __attribute__((ext_vector_type(4)));
__device__ __forceinline__ int crow(int r, int hi) { return (r & 3) + 8 * (r >> 2) + 4 * hi; }
__device__ __forceinline__ float hsum(float v) { auto rr = __builtin_amdgcn_permlane32_swap(__float_as_uint(v), __float_as_uint(v), false, false); return __uint_as_float(rr[0]) + __uint_as_float(rr[1]); }
struct GateW { float w[16]; float bias; };
__device__ __forceinline__ void gate_load(GateW& W, const float* w2, const float* gb, int h, int lane) {
#pragma unroll
    for (int r = 0; r < 16; ++r) W.w[r] = w2[r * 256 + h * 64 + lane];
    W.bias = gb[h * 64 + lane];
}
__device__ __forceinline__ void g2_scan(bf16* US, const float* DEC, int gtid, int gthreads) {
    for (int g = gtid; g < 64 * 128 * 16; g += gthreads) {
        const int kg = g & 15, dv = (g >> 4) & 127, bh = g >> 11;
        float st[4] = {0.f, 0.f, 0.f, 0.f};
#pragma unroll 1
        for (int cb = 0; cb < 4; ++cb) {
            u32x2 uv[8]; f32x4 dc[8];
#pragma unroll
            for (int i = 0; i < 8; ++i) { const int c = cb * 8 + i; uv[i] = *(const u32x2*)(US + ((size_t)(bh * 32 + c) * 128 + dv) * 64 + kg * 4); dc[i] = *(const f32x4*)(DEC + (size_t)(bh * 32 + c) * 64 + kg * 4); }
#pragma unroll
            for (int i = 0; i < 8; ++i) { const int c = cb * 8 + i; u32x2 o; o.x = pk2(st[0], st[1]); o.y = pk2(st[2], st[3]);
                *(u32x2*)(US + ((size_t)(bh * 32 + c) * 128 + dv) * 64 + kg * 4) = o;
                st[0] = st[0] * dc[i][0] + __uint_as_float(uv[i].x << 16); st[1] = st[1] * dc[i][1] + __uint_as_float(uv[i].x & 0xffff0000u);
                st[2] = st[2] * dc[i][2] + __uint_as_float(uv[i].y << 16); st[3] = st[3] * dc[i][3] + __uint_as_float(uv[i].y & 0xffff0000u); }
        }
    }
}
}
namespace gla2 {
using gla::f32x16; using gla::u32x4; using gla::u32x2; using gla::s16x4; using gla::crow; using gla::hsum; using gla::GateW; using gla::gate_load;
constexpr int ST = 144, VS = 320;
constexpr int L_SEG = 0, L_V = 2048, L_KR = L_V + 64 * VS, L_QR = L_KR + 64 * ST, L_KD = L_QR + 64 * ST, L_QE = L_KD + 64 * ST, L_KE = L_QE + 64 * ST, L_END = L_KE + 64 * ST;
constexpr int G3_QE = 0, G3_KE = 64 * ST, G3_V = 2 * 64 * ST, G3_RED = G3_V + 64 * VS, G3_END = G3_RED + 1024, G3_BUF = 40960;
static_assert(G3_END <= G3_BUF && L_END <= 131072, "gla2 LDS");
__device__ __forceinline__ s16x4 trr(int addr, int off) { s16x4 r; asm volatile("ds_read_b64_tr_b16 %0,%1 offset:%c2" : "=&v"(r) : "v"(addr), "i"(off) : "memory"); return r; }
struct G1Ld { unsigned g2; u32x4 k, q, v0, v1; };
__device__ __forceinline__ void g1_load(G1Ld& L, int u, const bf16* z) {
    const int tid = threadIdx.x, lane = tid & 63; const int wv = __builtin_amdgcn_readfirstlane(tid >> 6);
    const int bh = u >> 5, c = u & 31, b = bh >> 2, h = bh & 3, row0 = b * SEQ + 64 * c;
    L.g2 = *(const unsigned*)(z + (size_t)(row0 + 8 * wv + (lane >> 3)) * ZW + Z_GL + (lane & 7) * 2);
    const bf16* zr = z + (size_t)(row0 + (tid >> 3)) * ZW;
    L.k = *(const u32x4*)(zr + Z_GK + h * 64 + (tid & 7) * 8); L.q = *(const u32x4*)(zr + Z_GQ + h * 64 + (tid & 7) * 8);
    const bf16* zv = z + (size_t)(row0 + (tid >> 4)) * ZW + Z_GV + h * 128 + (tid & 15) * 8;
    L.v0 = *(const u32x4*)zv; L.v1 = *(const u32x4*)(zv + (size_t)32 * ZW);
}
__device__ __forceinline__ void g1_unit(int u, const G1Ld& L, const GateW& W, bf16* US, float* DEC, bf16* QED, bf16* KED, LAS unsigned char* shm) {
    const int tid = threadIdx.x, lane = tid & 63, r32 = lane & 31, hi = lane >> 5; const int wv = __builtin_amdgcn_readfirstlane(tid >> 6);
    const int bh = u >> 5, c = u & 31;
    *(LAS u32x4*)(shm + L_KR + (tid >> 3) * ST + (tid & 7) * 16) = L.k; *(LAS u32x4*)(shm + L_QR + (tid >> 3) * ST + (tid & 7) * 16) = L.q;
    *(LAS u32x4*)(shm + L_V + (tid >> 4) * VS + (tid & 15) * 16) = L.v0; *(LAS u32x4*)(shm + L_V + (32 + (tid >> 4)) * VS + (tid & 15) * 16) = L.v1;
    float bc[8]; float run = 0.f;
#pragma unroll
    for (int i = 0; i < 8; ++i) { float y = W.bias;
#pragma unroll
        for (int r2 = 0; r2 < 8; ++r2) { const unsigned gw = (unsigned)__builtin_amdgcn_readlane((int)L.g2, i * 8 + r2); y += __uint_as_float(gw << 16) * W.w[2 * r2] + __uint_as_float(gw & 0xffff0000u) * W.w[2 * r2 + 1]; }
        const float la = (fminf(y, 0.f) - __logf(1.f + __expf(-fabsf(y)))) * (1.f / 16.f);
        run += la; bc[i] = run; }
    LAS float* segt = (LAS float*)(shm + L_SEG);
    segt[wv * 64 + lane] = run;
    LDS_BARRIER();
    { float pre = 0.f, tot = 0.f;
#pragma unroll
      for (int s = 0; s < 8; ++s) { const float v = segt[s * 64 + lane]; tot += v; if (s < wv) pre += v; }
      const LAS bf16* kr = (const LAS bf16*)(shm + L_KR) + (8 * wv) * (ST / 2) + lane; const LAS bf16* qr = (const LAS bf16*)(shm + L_QR) + (8 * wv) * (ST / 2) + lane;
      LAS bf16* qe = (LAS bf16*)(shm + L_QE) + (8 * wv) * (ST / 2) + lane; LAS bf16* ke = (LAS bf16*)(shm + L_KE) + (8 * wv) * (ST / 2) + lane;
      float kd[8];
#pragma unroll
      for (int i = 0; i < 8; ++i) { const float bci = bc[i] + pre; const float kv = bf2f(kr[i * (ST / 2)]), qv = bf2f(qr[i * (ST / 2)]); const float e = __expf(bci);
          kd[i] = kv * __expf(tot - bci); qe[i * (ST / 2)] = (bf16)f2bf(qv * 0.125f * e); ke[i * (ST / 2)] = (bf16)f2bf(kv * __builtin_amdgcn_rcpf(e)); }
      u32x4 o; o.x = pg8::cvt_pk_bf16(kd[0], kd[1]); o.y = pg8::cvt_pk_bf16(kd[2], kd[3]); o.z = pg8::cvt_pk_bf16(kd[4], kd[5]); o.w = pg8::cvt_pk_bf16(kd[6], kd[7]);
      *(LAS u32x4*)(shm + L_KD + lane * ST + wv * 16) = o;
      if (wv == 0) DEC[(size_t)(bh * 32 + c) * 64 + lane] = __expf(tot); }
    LDS_BARRIER();
    { const int dvb = wv >> 1, kb = wv & 1; f32x16 acc = f32x16{};
      const int va = (int)(unsigned)(uintptr_t)(shm + L_V) + (8 * hi + ((lane & 15) >> 2)) * VS + (32 * dvb + 16 * ((lane >> 4) & 1) + 4 * (lane & 3)) * 2;
      s16x4 lo[4], h4[4];
#pragma unroll
      for (int ks = 0; ks < 4; ++ks) { lo[ks] = trr(va, ks * 16 * VS); h4[ks] = trr(va, ks * 16 * VS + 4 * VS); }
      asm volatile("s_waitcnt lgkmcnt(0)" ::: "memory"); __builtin_amdgcn_sched_barrier(0);
      bf16x8 bb[4];
#pragma unroll
      for (int ks = 0; ks < 4; ++ks) bb[ks] = *(const LAS bf16x8*)(shm + L_KD + (32 * kb + r32) * ST + ks * 32 + hi * 16);
      asm volatile("s_waitcnt lgkmcnt(0)" ::: "memory"); __builtin_amdgcn_sched_barrier(0);
#pragma unroll
      for (int ks = 0; ks < 4; ++ks) { const bf16x8 a = (bf16x8){lo[ks][0], lo[ks][1], lo[ks][2], lo[ks][3], h4[ks][0], h4[ks][1], h4[ks][2], h4[ks][3]};
          acc = __builtin_amdgcn_mfma_f32_32x32x16_bf16(bb[ks], a, acc, 0, 0, 0); }
      const u32x4 qd = *(const LAS u32x4*)(shm + L_QE + (tid >> 3) * ST + (tid & 7) * 16), kdd = *(const LAS u32x4*)(shm + L_KE + (tid >> 3) * ST + (tid & 7) * 16);
      *(u32x4*)(QED + (size_t)u * 4096 + tid * 8) = qd; *(u32x4*)(KED + (size_t)u * 4096 + tid * 8) = kdd;
      bf16* up = US + ((size_t)(bh * 32 + c) * 128 + 32 * dvb + r32) * 64 + 32 * kb + 4 * hi;
#pragma unroll
      for (int g = 0; g < 4; ++g) { u32x2 ow; ow.x = fa::cvtpk(acc[4 * g], acc[4 * g + 1]); ow.y = fa::cvtpk(acc[4 * g + 2], acc[4 * g + 3]); *(u32x2*)(up + 8 * g) = ow; } }
    LDS_BARRIER();
}
struct G3Ld { u32x4 q, k, v0, v1; bf16x8 sfr[4]; u32x2 grw[4]; };
__device__ __forceinline__ void g3_load(G3Ld& X, int u, const bf16* z, const bf16* US, const bf16* QED, const bf16* KED) {
    const int tid = threadIdx.x, lane = tid & 63, r32 = lane & 31, hi = lane >> 5; const int wv = __builtin_amdgcn_readfirstlane(tid >> 6);
    const int bh = u >> 5, c = u & 31, b = bh >> 2, h = bh & 3, row0 = b * SEQ + 64 * c;
    const int dvb = wv >> 1, tb = wv & 1;
    X.q = *(const u32x4*)(QED + (size_t)u * 4096 + tid * 8); X.k = *(const u32x4*)(KED + (size_t)u * 4096 + tid * 8);
    const bf16* zv = z + (size_t)(row0 + (tid >> 4)) * ZW + Z_GV + h * 128 + (tid & 15) * 8;
    X.v0 = *(const u32x4*)zv; X.v1 = *(const u32x4*)(zv + (size_t)32 * ZW);
    { const bf16* sp = US + ((size_t)(bh * 32 + c) * 128 + 32 * dvb + r32) * 64 + hi * 8;
#pragma unroll
      for (int ks = 0; ks < 4; ++ks) X.sfr[ks] = *(const bf16x8*)(sp + ks * 16); }
    { const bf16* gr = z + (size_t)(row0 + 32 * tb + r32) * ZW + Z_GR + h * 128 + 32 * dvb + 4 * hi;
#pragma unroll
      for (int g = 0; g < 4; ++g) X.grw[g] = *(const u32x2*)(gr + 8 * g); }
}
__device__ __forceinline__ void g3_unit(int u, const G3Ld& X, const float* gon, bf16* MIXO, LAS unsigned char* shm0, int buf) {
    const int tid = threadIdx.x, lane = tid & 63, r32 = lane & 31, hi = lane >> 5; const int wv = __builtin_amdgcn_readfirstlane(tid >> 6);
    const int bh = u >> 5, c = u & 31, b = bh >> 2, h = bh & 3, row0 = b * SEQ + 64 * c;
    const int dvb = wv >> 1, tb = wv & 1;
    LAS unsigned char* shm = shm0 + buf * G3_BUF;
    f32x4 gnv[4];
#pragma unroll
    for (int g = 0; g < 4; ++g) gnv[g] = *(const f32x4*)(gon + 32 * dvb + 8 * g + 4 * hi);
    *(LAS u32x4*)(shm + G3_QE + (tid >> 3) * ST + (tid & 7) * 16) = X.q; *(LAS u32x4*)(shm + G3_KE + (tid >> 3) * ST + (tid & 7) * 16) = X.k;
    *(LAS u32x4*)(shm + G3_V + (tid >> 4) * VS + (tid & 15) * 16) = X.v0; *(LAS u32x4*)(shm + G3_V + (32 + (tid >> 4)) * VS + (tid & 15) * 16) = X.v1;
    LDS_BARRIER();
    f32x16 o = f32x16{};
    bf16x8 qf[4];
#pragma unroll
    for (int ks = 0; ks < 4; ++ks) qf[ks] = *(const LAS bf16x8*)(shm + G3_QE + (32 * tb + r32) * ST + ks * 32 + hi * 16);
    const int va = (int)(unsigned)(uintptr_t)(shm + G3_V) + (4 * hi + ((lane & 15) >> 2)) * VS + (32 * dvb + 16 * ((lane >> 4) & 1) + 4 * (lane & 3)) * 2;
    s16x4 vl[4], vh[4];
#pragma unroll
    for (int j = 0; j < 4; ++j) { if ((j >> 1) <= tb) { vl[j] = trr(va, j * 16 * VS); vh[j] = trr(va, j * 16 * VS + 8 * VS); } else { vl[j] = s16x4{}; vh[j] = s16x4{}; } }
    asm volatile("s_waitcnt lgkmcnt(0)" ::: "memory"); __builtin_amdgcn_sched_barrier(0);
#pragma unroll
    for (int ks = 0; ks < 4; ++ks) o = __builtin_amdgcn_mfma_f32_32x32x16_bf16(X.sfr[ks], qf[ks], o, 0, 0, 0);
    asm volatile("s_waitcnt lgkmcnt(0)" ::: "memory"); __builtin_amdgcn_sched_barrier(0);
#pragma unroll
    for (int sb = 0; sb < 2; ++sb) {
        if (sb <= tb) {
            f32x16 sc = f32x16{};
#pragma unroll
            for (int ks = 0; ks < 4; ++ks) { const bf16x8 a = *(const LAS bf16x8*)(shm + G3_KE + (32 * sb + r32) * ST + ks * 32 + hi * 16); sc = __builtin_amdgcn_mfma_f32_32x32x16_bf16(a, qf[ks], sc, 0, 0, 0); }
            if (sb == tb) {
#pragma unroll
                for (int r = 0; r < 16; ++r) sc[r] = (crow(r, hi) <= r32) ? sc[r] : 0.f; }
#pragma unroll
            for (int kk = 0; kk < 2; ++kk) { const int j = sb * 2 + kk;
                u32x4 pw; pw.x = fa::cvtpk(sc[8 * kk], sc[8 * kk + 1]); pw.y = fa::cvtpk(sc[8 * kk + 2], sc[8 * kk + 3]); pw.z = fa::cvtpk(sc[8 * kk + 4], sc[8 * kk + 5]); pw.w = fa::cvtpk(sc[8 * kk + 6], sc[8 * kk + 7]);
                const bf16x8 av = (bf16x8){vl[j][0], vl[j][1], vl[j][2], vl[j][3], vh[j][0], vh[j][1], vh[j][2], vh[j][3]};
                o = __builtin_amdgcn_mfma_f32_32x32x16_bf16(av, __builtin_bit_cast(bf16x8, pw), o, 0, 0, 0); }
        }
    }
    { float ss = 0.f;
#pragma unroll
      for (int r = 0; r < 16; ++r) ss += o[r] * o[r];
      ss = hsum(ss);
      LAS float* red = (LAS float*)(shm + G3_RED);
      if (hi == 0) red[dvb * 64 + 32 * tb + r32] = ss;
      LDS_BARRIER();
      const int t = 32 * tb + r32;
      const float tot = (red[t] + red[64 + t]) + (red[128 + t] + red[192 + t]);
      const float rn = __builtin_amdgcn_rsqf(tot * (1.f / 128.f) + EPS);
      bf16* mp = MIXO + (size_t)(row0 + t) * DM + h * 128 + 32 * dvb + 4 * hi;
#pragma unroll
      for (int g = 0; g < 4; ++g) { const u32x2 gw = X.grw[g]; const f32x4 gn = gnv[g];
          float gv[4] = {__uint_as_float(gw.x << 16), __uint_as_float(gw.x & 0xffff0000u), __uint_as_float(gw.y << 16), __uint_as_float(gw.y & 0xffff0000u)}; float v[4];
#pragma unroll
          for (int e = 0; e < 4; ++e) { const float sl = gv[e] * __builtin_amdgcn_rcpf(1.f + __expf(-gv[e])); v[e] = o[4 * g + e] * rn * gn[e] * sl; }
          u32x2 ow; ow.x = pg8::cvt_pk_bf16(v[0], v[1]); ow.y = pg8::cvt_pk_bf16(v[2], v[3]); *(u32x2*)(mp + 8 * g) = ow; } }
}
}
namespace prep2 {
using prep::f32x16; using prep::u32x4; using prep::u32x2; using prep::f32x2; using prep::crow; using prep::hsum;
constexpr int L_WQ = 0, L_WKV = 49152, L_STG = 81920  , L_G = 132096  , QROW = 192;
static_assert(L_STG + 8 * 6144 <= 131072 && L_G + 768 <= LDS_BYTES && 32 * QROW <= 6144, "prep2 LDS");
__device__ __forceinline__ float sumsq8(const u32x4 w) { const float a0 = __uint_as_float(w.x << 16), a1 = __uint_as_float(w.x & 0xffff0000u), a2 = __uint_as_float(w.y << 16), a3 = __uint_as_float(w.y & 0xffff0000u),
    a4 = __uint_as_float(w.z << 16), a5 = __uint_as_float(w.z & 0xffff0000u), a6 = __uint_as_float(w.w << 16), a7 = __uint_as_float(w.w & 0xffff0000u);
    return ((a0 * a0 + a1 * a1) + (a2 * a2 + a3 * a3)) + ((a4 * a4 + a5 * a5) + (a6 * a6 + a7 * a7)); }
template <int ABL = 0> __device__ __forceinline__ void prep_phase(int vcu, int G, const bf16* z, const unsigned char* latq, const unsigned char* latkv, const unsigned char* wuqf, const unsigned char* wukvf, const f32x2* rope, const float* nq, const float* nk, bf16* Q, bf16* K, bf16* V, LAS unsigned char* shm) {
    const int tid = threadIdx.x, lane = tid & 63, r32 = lane & 31, hi = lane >> 5; const int wv = __builtin_amdgcn_readfirstlane(tid >> 6);
    for (int u = vcu; u < 256; u += G) {
        const int h = u & 7, rc = u >> 3;
        { const u32x4* sq = (const u32x4*)(wuqf + (size_t)h * 49152); const u32x4* sk = (const u32x4*)(wukvf + (size_t)h * 32768);
#pragma unroll
          for (int i = 0; i < 6; ++i) *(LAS u32x4*)(shm + L_WQ + (i * 512 + tid) * 16) = sq[i * 512 + tid];
#pragma unroll
          for (int i = 0; i < 4; ++i) *(LAS u32x4*)(shm + L_WKV + (i * 512 + tid) * 16) = sk[i * 512 + tid];
          if (tid < 96) ((LAS float*)(shm + L_G))[tid] = nq[tid]; else if (tid < 192) ((LAS float*)(shm + L_G))[tid] = nk[tid - 96]; }
        __syncthreads();
        const LAS float* gq = (const LAS float*)(shm + L_G); const LAS float* gk = gq + 96;
        LAS unsigned char* stg = shm + L_STG + wv * 6144;
        const unsigned char* lqb = latq + (size_t)rc * (32 * 16384); const unsigned char* lkb = latkv + (size_t)rc * (32 * 8192);
#pragma unroll 1
        for (int bi = wv; bi < 32; bi += 8) {
            const int row = rc * 1024 + bi * 32 + r32, b = row >> 11, s = row & 2047;
            const bf16* zr = z + (size_t)row * ZW;
            u32x4 cq[16], ckv[8]; u32x2 krw[4]; u32x4 rp[4];
#pragma unroll
            for (int ks = 0; ks < 16; ++ks) cq[ks] = *(const u32x4*)(lqb + (unsigned)(bi * 16384 + ks * 1024 + lane * 16));
            { const u32x4* rr = (const u32x4*)(rope + (size_t)row * 16); rp[0] = rr[2 * hi]; rp[1] = rr[2 * hi + 1]; rp[2] = rr[4 + 2 * hi]; rp[3] = rr[4 + 2 * hi + 1]; }
            float ssq = 0.f, sskv = 0.f;
#pragma unroll
            for (int ks = 0; ks < 16; ++ks) ssq += sumsq8(cq[ks]);
            const float rq = __builtin_amdgcn_rsqf(hsum(ssq) * (1.f / 256.f) + EPS);
            float cs[8], sn[8];
#pragma unroll
            for (int j = 0; j < 4; ++j) { const int a = j >> 1; const bool odd = j & 1;
                cs[j] = __uint_as_float(odd ? rp[a].z : rp[a].x); sn[j] = __uint_as_float(odd ? rp[a].w : rp[a].y);
                cs[4 + j] = __uint_as_float(odd ? rp[2 + a].z : rp[2 + a].x); sn[4 + j] = __uint_as_float(odd ? rp[2 + a].w : rp[2 + a].y); }
            { f32x16 acc[3]; acc[0] = f32x16{}; acc[1] = f32x16{}; acc[2] = f32x16{};
#pragma unroll
              for (int ks = 0; ks < 16; ++ks)
#pragma unroll
                  for (int nb = 0; nb < 3; ++nb) { const bf16x8 a = *(const LAS bf16x8*)(shm + L_WQ + ((nb * 16 + ks) * 64 + lane) * 16);
                      if (!(ABL & 1)) acc[nb] = __builtin_amdgcn_mfma_f32_32x32x16_bf16(a, __builtin_bit_cast(bf16x8, cq[ks]), acc[nb], 0, 0, 0); else asm volatile("" :: "v"(a), "v"(cq[ks])); }
#pragma unroll
              for (int ks = 0; ks < 8; ++ks) ckv[ks] = *(const u32x4*)(lkb + (unsigned)(bi * 8192 + ks * 1024 + lane * 16));
#pragma unroll
              for (int g = 0; g < 4; ++g) krw[g] = *(const u32x2*)(zr + Z_KR + 8 * g + 4 * hi);
              float ss = 0.f;
#pragma unroll
              for (int nb = 0; nb < 3; ++nb)
#pragma unroll
                  for (int r = 0; r < 16; ++r) ss += acc[nb][r] * acc[nb][r];
              ss = hsum(ss) * rq * rq; const float sc = __builtin_amdgcn_rsqf(ss * (1.f / 96.f) + EPS) * rq * QSCALE;
#pragma unroll
              for (int nb = 0; nb < 3; ++nb) { float v[16];
#pragma unroll
                  for (int r = 0; r < 16; ++r) v[r] = acc[nb][r] * sc * gq[32 * nb + crow(r, hi)];
                  if (nb == 2) {
#pragma unroll
                      for (int r = 0; r < 8; ++r) { const float x1 = v[r], x2 = v[r + 8]; v[r] = x1 * cs[r] - x2 * sn[r]; v[r + 8] = x2 * cs[r] + x1 * sn[r]; } }
#pragma unroll
                  for (int g = 0; g < 4; ++g) { u32x2 o; o.x = pg8::cvt_pk_bf16(v[4 * g], v[4 * g + 1]); o.y = pg8::cvt_pk_bf16(v[4 * g + 2], v[4 * g + 3]); *(LAS u32x2*)(stg + r32 * QROW + (32 * nb + 8 * g + 4 * hi) * 2) = o; } }
              asm volatile("s_waitcnt lgkmcnt(0)" ::: "memory");
              bf16* qb = Q + ((size_t)(b * MH + h) * SEQ + (s - r32)) * QKD;
#pragma unroll
              for (int j = 0; j < 6; ++j) { const int i = lane + 64 * j, t = i / 12, c = i - 12 * t; const u32x4 w = *(const LAS u32x4*)(stg + t * QROW + c * 16); if (!(ABL & 2)) *(u32x4*)(qb + i * 8) = w; else asm volatile("" :: "v"(w)); }
              asm volatile("s_waitcnt lgkmcnt(0)" ::: "memory"); }
#pragma unroll
            for (int ks = 0; ks < 8; ++ks) sskv += sumsq8(ckv[ks]);
            const float rkv = __builtin_amdgcn_rsqf(hsum(sskv) * (1.f / 128.f) + EPS);
            { f32x16 acc[2]; acc[0] = f32x16{}; acc[1] = f32x16{};
#pragma unroll
              for (int ks = 0; ks < 8; ++ks)
#pragma unroll
                  for (int nb = 0; nb < 2; ++nb) { const bf16x8 a = *(const LAS bf16x8*)(shm + L_WKV + ((nb * 8 + ks) * 64 + lane) * 16);
                      if (!(ABL & 1)) acc[nb] = __builtin_amdgcn_mfma_f32_32x32x16_bf16(a, __builtin_bit_cast(bf16x8, ckv[ks]), acc[nb], 0, 0, 0); else asm volatile("" :: "v"(a), "v"(ckv[ks])); }
              float kr[16]; float ss = 0.f, sk = 0.f;
#pragma unroll
              for (int g = 0; g < 4; ++g) { kr[4 * g] = __uint_as_float(krw[g].x << 16); kr[4 * g + 1] = __uint_as_float(krw[g].x & 0xffff0000u); kr[4 * g + 2] = __uint_as_float(krw[g].y << 16); kr[4 * g + 3] = __uint_as_float(krw[g].y & 0xffff0000u); }
#pragma unroll
              for (int r = 0; r < 16; ++r) sk += kr[r] * kr[r];
#pragma unroll
              for (int nb = 0; nb < 2; ++nb)
#pragma unroll
                  for (int r = 0; r < 16; ++r) ss += acc[nb][r] * acc[nb][r];
              ss = hsum(ss * rkv * rkv + sk); const float rk = __builtin_amdgcn_rsqf(ss * (1.f / 96.f) + EPS);
              bf16* kp = K + ((size_t)(b * MH + h) * 32 + (s >> 6)) * (12 * 64 * 8) + (s & 63) * 8;
#pragma unroll
              for (int nb = 0; nb < 3; ++nb) { float v[16];
                  if (nb < 2) {
#pragma unroll
                      for (int r = 0; r < 16; ++r) v[r] = acc[nb < 2 ? nb : 0][r] * (rk * rkv) * gk[32 * nb + crow(r, hi)];
                  } else {
#pragma unroll
                      for (int r = 0; r < 16; ++r) v[r] = kr[r] * rk * gk[64 + crow(r, hi)];
#pragma unroll
                      for (int r = 0; r < 8; ++r) { const float x1 = v[r], x2 = v[r + 8]; v[r] = x1 * cs[r] - x2 * sn[r]; v[r + 8] = x2 * cs[r] + x1 * sn[r]; } }
#pragma unroll
                  for (int g = 0; g < 4; ++g) { u32x2 o; o.x = pg8::cvt_pk_bf16(v[4 * g], v[4 * g + 1]); o.y = pg8::cvt_pk_bf16(v[4 * g + 2], v[4 * g + 3]); if (!(ABL & 2)) *(u32x2*)(kp + (4 * nb + g) * 512 + 4 * hi) = o; else asm volatile("" :: "v"(o)); } } }
            { f32x16 acc[2]; acc[0] = f32x16{}; acc[1] = f32x16{};
#pragma unroll
              for (int ks = 0; ks < 8; ++ks)
#pragma unroll
                  for (int nb = 0; nb < 2; ++nb) { const bf16x8 a = *(const LAS bf16x8*)(shm + L_WKV + (((2 + nb) * 8 + ks) * 64 + lane) * 16);
                      if (!(ABL & 1)) acc[nb] = __builtin_amdgcn_mfma_f32_32x32x16_bf16(a, __builtin_bit_cast(bf16x8, ckv[ks]), acc[nb], 0, 0, 0); else asm volatile("" :: "v"(a), "v"(ckv[ks])); }
#pragma unroll
              for (int nb = 0; nb < 2; ++nb)
#pragma unroll
                  for (int g = 0; g < 4; ++g) { u32x2 o; o.x = pg8::cvt_pk_bf16(acc[nb][4 * g] * rkv, acc[nb][4 * g + 1] * rkv); o.y = pg8::cvt_pk_bf16(acc[nb][4 * g + 2] * rkv, acc[nb][4 * g + 3] * rkv);
                      *(LAS u32x2*)(stg + ((nb * 2 + (r32 >> 4)) * 16 + (r32 & 15)) * 64 + (8 * g + 4 * hi) * 2) = o; }
              asm volatile("s_waitcnt lgkmcnt(0)" ::: "memory");
              bf16* vt = V + ((size_t)(b * MH + h) * 32 + (s >> 6)) * 4096 + (((s - r32) & 63) >> 4) * 512;
#pragma unroll
              for (int pc = 0; pc < 4; ++pc) { const u32x4 w = *(const LAS u32x4*)(stg + pc * 1024 + lane * 16); if (!(ABL & 2)) *(u32x4*)(vt + (pc >> 1) * 2048 + (pc & 1) * 512 + lane * 8) = w; else asm volatile("" :: "v"(w)); }
              asm volatile("s_waitcnt lgkmcnt(0)" ::: "memory"); }
        }
        __syncthreads();
    }
}
}
namespace fa2 {
using namespace fa;
__device__ __forceinline__ float max3f(float a, float b, float c) { float r; asm("v_max3_f32 %0, %1, %2, %3" : "=v"(r) : "v"(a), "v"(b), "v"(c)); return r; }
__device__ __forceinline__ float max2f(float a, float b) { float r; asm("v_max_f32_e32 %0, %1, %2" : "=v"(r) : "v"(a), "v"(b)); return r; }
__device__ __forceinline__ void glds16s(unsigned voff, const void* sbase, unsigned lds_dst) { unsigned keep;
    asm volatile("s_mov_b32 %0, m0\n\ts_mov_b32 m0, %2\n\ts_nop 0\n\tglobal_load_lds_dwordx4 %1, %3\n\ts_mov_b32 m0, %0" : "=&s"(keep) : "v"(voff), "s"(lds_dst), "s"(sbase) : "memory"); }
__device__ __forceinline__ void qkt2(f32x16& p0, f32x16& p1, const LAS unsigned char* Kslot, const bf16x8* qr, const f32x16& negm, int r32, int hi) {
    const LAS unsigned char* kb = Kslot + hi * 1024 + r32 * 16;
#pragma unroll
    for (int d0 = 0; d0 < 6; ++d0) {
        const bf16x8 b0 = *(const LAS bf16x8*)(kb + d0 * 2048);
        const bf16x8 b1 = *(const LAS bf16x8*)(kb + d0 * 2048 + 512);
        if (d0 == 0) { p0 = __builtin_amdgcn_mfma_f32_32x32x16_bf16(b0, qr[0], negm, 0, 0, 0); p1 = __builtin_amdgcn_mfma_f32_32x32x16_bf16(b1, qr[0], negm, 0, 0, 0); }
        else { p0 = __builtin_amdgcn_mfma_f32_32x32x16_bf16(b0, qr[d0], p0, 0, 0, 0); p1 = __builtin_amdgcn_mfma_f32_32x32x16_bf16(b1, qr[d0], p1, 0, 0, 0); } }
}
__device__ __forceinline__ float rowmax2(const f32x16& p0, const f32x16& p1) {
    float a = max3f(p0[0], p0[1], p1[0]), b = max3f(p0[2], p0[3], p1[1]); a = max3f(a, p1[2], p1[3]);
#pragma unroll
    for (int r = 4; r < 16; r += 4) { a = max3f(a, p0[r], p0[r + 1]); b = max3f(b, p0[r + 2], p0[r + 3]); a = max3f(a, p1[r], p1[r + 1]); b = max3f(b, p1[r + 2], p1[r + 3]); }
    const float m = max2f(a, b);
    auto rr = __builtin_amdgcn_permlane32_swap(__float_as_uint(m), __float_as_uint(m), false, false);
    return max2f(__uint_as_float(rr[0]), __uint_as_float(rr[1]));
}
#define FA2_BAR0() asm volatile("s_waitcnt vmcnt(0) lgkmcnt(0)\n\ts_barrier" ::: "memory")
#define FA2_BAR3() asm volatile("s_waitcnt vmcnt(3) lgkmcnt(0)\n\ts_barrier" ::: "memory")
#define FA2_SUMPACK(P0, P1) do { float s_ = 0.f; _Pragma("unroll") for (int r = 0; r < 16; ++r) s_ += P0[r] + P1[r]; l += s_; \
    pw0 = (u32x4){cvtpk(P0[0], P0[1]), cvtpk(P0[2], P0[3]), cvtpk(P0[4], P0[5]), cvtpk(P0[6], P0[7])}; \
    pw1 = (u32x4){cvtpk(P0[8], P0[9]), cvtpk(P0[10], P0[11]), cvtpk(P0[12], P0[13]), cvtpk(P0[14], P0[15])}; \
    pw2 = (u32x4){cvtpk(P1[0], P1[1]), cvtpk(P1[2], P1[3]), cvtpk(P1[4], P1[5]), cvtpk(P1[6], P1[7])}; \
    pw3 = (u32x4){cvtpk(P1[8], P1[9]), cvtpk(P1[10], P1[11]), cvtpk(P1[12], P1[13]), cvtpk(P1[14], P1[15])}; } while (0)
#define FA2_PV(slot) pv(o, vb0 + (slot) * VSLOT, __builtin_bit_cast(bf16x8, pw0), __builtin_bit_cast(bf16x8, pw1), __builtin_bit_cast(bf16x8, pw2), __builtin_bit_cast(bf16x8, pw3))
template <int THR, int ABL = 0> __device__ __forceinline__ void attn_unit2(int bh, int qb, const bf16* Q, const bf16* K, const bf16* V, bf16* MIXO, LAS unsigned char* shm) {
    const int tid = threadIdx.x, lane = tid & 63, r32 = lane & 31, hi = lane >> 5; const int wid = __builtin_amdgcn_readfirstlane(tid >> 6);
    const int b = bh >> 3, h = bh & 7, q0 = qb * 256;
    const bf16* Qw = Q + ((size_t)bh * 2048 + q0 + wid * 32) * 96;
    const bf16* Kh = K + (size_t)bh * 32 * (12 * 64 * 8); const bf16* Vh = V + (size_t)bh * 32 * 4096;
    const unsigned lds0 = (unsigned)(uintptr_t)shm;
    LAS float* wsf = (LAS float*)(shm + L_WS) + wid * 64;
    const int c1 = wid, c2 = 8 + (wid & 3);
    const bf16* ksrc1 = Kh + c1 * 512; const bf16* ksrc2 = Kh + c2 * 512; const bf16* vsrc = Vh + wid * 512;
    const unsigned voff = (unsigned)lane * 16u;
    const unsigned kdst1 = lds0 + L_K + c1 * 1024, kdst2 = lds0 + L_K + c2 * 1024, vdst = lds0 + L_V + wid * 1024;
#define FA2_DMA(t) do { const int t_ = (t); const int sl_ = t_ & 3; glds16s(voff, ksrc1 + (size_t)t_ * (12 * 64 * 8), (unsigned)__builtin_amdgcn_readfirstlane(kdst1 + sl_ * KSLOT)); \
        glds16s(voff, ksrc2 + (size_t)t_ * (12 * 64 * 8), (unsigned)__builtin_amdgcn_readfirstlane(kdst2 + sl_ * KSLOT)); \
        glds16s(voff, vsrc + (size_t)t_ * 4096, (unsigned)__builtin_amdgcn_readfirstlane(vdst + sl_ * VSLOT)); } while (0)
    const int vb0 = (int)(lds0 + L_V) + ((lane >> 4) & 1) * 32 + (lane & 3) * 8 + (4 * hi + ((lane & 15) >> 2)) * 64;
    const int NT = 4 * qb + 4, tw = 4 * qb + (wid >> 1);
    FA2_DMA(0); FA2_DMA(1);
    bf16x8 qr[6];
#pragma unroll
    for (int d0 = 0; d0 < 6; ++d0) qr[d0] = *(const bf16x8*)(Qw + (size_t)r32 * 96 + d0 * 16 + hi * 8);
#pragma unroll
    for (int d0 = 0; d0 < 6; ++d0) asm volatile("" : "+v"(qr[d0]));
    float mhat = 0.f, l = 0.f; f32x16 o[2]; o[0] = f32x16{}; o[1] = f32x16{}; f32x16 negm = f32x16{}; asm volatile("" : "+v"(negm));
    u32x4 pw0, pw1, pw2, pw3;
    FA2_BAR0();
    FA2_DMA(2);
    { f32x16 c0, c1; qkt2(c0, c1, shm + L_K, qr, negm, r32, hi); asm volatile("s_nop 15\n\ts_nop 7" : "+v"(c0), "+v"(c1));
      const float rm = rowmax2(c0, c1); mhat = rm;
#pragma unroll
      for (int r = 0; r < 16; ++r) { c0[r] = __builtin_amdgcn_exp2f(c0[r] - rm); c1[r] = __builtin_amdgcn_exp2f(c1[r] - rm); }
#pragma unroll
      for (int r = 0; r < 16; ++r) negm[r] = -mhat;
      asm volatile("" : "+v"(negm));
      FA2_SUMPACK(c0, c1); }
    FA2_BAR3();
    for (int t = 1; t < NT; ++t) {
        if (!(ABL & 1)) FA2_DMA((t + 2 < NT) ? t + 2 : NT - 1);
        if (t <= tw + 1) {
            f32x16 c0, c1; bool resc = false;
            if (t <= tw) { qkt2(c0, c1, shm + L_K + (t & 3) * KSLOT, qr, negm, r32, hi); asm volatile("s_nop 15\n\ts_nop 7" : "+v"(c0), "+v"(c1)); }
            else {
#pragma unroll
                for (int r = 0; r < 16; ++r) { c0[r] = -INFINITY; c1[r] = -INFINITY; }
                asm volatile("" : "+v"(c0), "+v"(c1)); }
            const float rm = rowmax2(c0, c1);
            if (__any(rm > (float)THR)) { const float dl = fmaxf(rm, 0.f); mhat += dl;
#pragma unroll
                for (int r = 0; r < 16; ++r) { c0[r] -= dl; c1[r] -= dl; }
#pragma unroll
                for (int r = 0; r < 16; ++r) negm[r] = -mhat;
                asm volatile("" : "+v"(negm));
                const float f = __builtin_amdgcn_exp2f(-dl); l *= f; if (hi == 0) wsf[r32] = f; resc = true; }
            { const int vb = vb0 + ((t - 1) & 3) * VSLOT; s16x4 vl[8], vh[8];
#pragma unroll
              for (int i = 0; i < 8; ++i) {
                  asm volatile("ds_read_b64_tr_b16 %0,%1 offset:%c2" : "=&v"(vl[i]) : "v"(vb), "i"((i >> 2) * 4096 + (i & 3) * 1024) : "memory");
                  asm volatile("ds_read_b64_tr_b16 %0,%1 offset:%c2" : "=&v"(vh[i]) : "v"(vb), "i"((i >> 2) * 4096 + (i & 3) * 1024 + 512) : "memory"); }
              asm volatile("s_waitcnt lgkmcnt(0)" ::: "memory"); __builtin_amdgcn_sched_barrier(0);
#define FA2_VF(i) (bf16x8){vl[i][0], vl[i][1], vl[i][2], vl[i][3], vh[i][0], vh[i][1], vh[i][2], vh[i][3]}
#define FA2_GAP(D, KS, PW, X, B) do { if (!(ABL & 8)) o[D] = __builtin_amdgcn_mfma_f32_32x32x16_bf16(__builtin_bit_cast(bf16x8, PW), FA2_VF((D) * 4 + (KS)), o[D], 0, 0, 0); else asm volatile("" :: "v"(vl[(D) * 4 + (KS)]), "v"(vh[(D) * 4 + (KS)]), "v"(PW)); \
              if (!(ABL & 2)) { X[B] = __builtin_amdgcn_exp2f(X[B]); X[B + 1] = __builtin_amdgcn_exp2f(X[B + 1]); X[B + 2] = __builtin_amdgcn_exp2f(X[B + 2]); X[B + 3] = __builtin_amdgcn_exp2f(X[B + 3]); } \
              asm volatile("" : "+v"(X)); __builtin_amdgcn_sched_barrier(0); } while (0)
              FA2_GAP(0, 0, pw0, c0, 0); FA2_GAP(1, 0, pw0, c0, 4); FA2_GAP(0, 1, pw1, c0, 8); FA2_GAP(1, 1, pw1, c0, 12);
              FA2_GAP(0, 2, pw2, c1, 0); FA2_GAP(1, 2, pw2, c1, 4); FA2_GAP(0, 3, pw3, c1, 8); FA2_GAP(1, 3, pw3, c1, 12);
#undef FA2_GAP
#undef FA2_VF
            }
            FA2_SUMPACK(c0, c1);
            if (resc) {
#pragma unroll
                for (int r = 0; r < 16; ++r) { const float fr = wsf[crow(r, hi)]; o[0][r] *= fr; o[1][r] *= fr; } }
        }
        if (!(ABL & 16)) FA2_BAR3(); else asm volatile("s_waitcnt lgkmcnt(0)" ::: "memory");
    }
    if (tw == NT - 1) { FA2_PV(tw & 3); }
    { auto rr = __builtin_amdgcn_permlane32_swap(__float_as_uint(l), __float_as_uint(l), false, false); l = __uint_as_float(rr[0]) + __uint_as_float(rr[1]); }
    if (hi == 0) wsf[32 + r32] = l;
    float rli[16];
#pragma unroll
    for (int r = 0; r < 16; ++r) rli[r] = __builtin_amdgcn_rcpf(wsf[32 + crow(r, hi)]);
    bf16* Ow = MIXO + ((size_t)b * 2048 + q0 + wid * 32) * 1024 + 512 + h * 64;
    { LAS bf16* stg = (LAS bf16*)(shm + L_OST) + wid * 2048;
#pragma unroll
      for (int r = 0; r < 16; ++r) { const int orow = crow(r, hi);
#pragma unroll
          for (int d0 = 0; d0 < 2; ++d0) stg[orow * 64 + d0 * 32 + r32] = (bf16)f2bf(o[d0][r] * rli[r]); }
      asm volatile("s_waitcnt lgkmcnt(0)" ::: "memory");
#pragma unroll
      for (int i = 0; i < 4; ++i) { const int row = i * 8 + (lane >> 3), ch = lane & 7; const u32x4 v = *(const LAS u32x4*)(stg + row * 64 + ch * 8); *(u32x4*)(Ow + (size_t)row * 1024 + ch * 8) = v; } }
    FA2_BAR0();
#undef FA2_DMA
}
#ifndef ATTN_THR
#define ATTN_THR 8
#endif
template <int ABL = 0> __device__ __forceinline__ void attn_phase(int vcu, int G, const bf16* Q, const bf16* K, const bf16* V, bf16* MIXO, LAS unsigned char* shm) {
    for (int u = vcu; u < 256; u += G) {
        const int bh = u >> 1, half = u & 1;
#pragma unroll 1
        for (int i = 0; i < 4; ++i) { const int qb = half ? (i == 0 ? 6 : i == 1 ? 1 : i == 2 ? 4 : 3) : (i == 0 ? 7 : i == 1 ? 0 : i == 2 ? 5 : 2); attn_unit2<ATTN_THR, ABL>(bh, qb, Q, K, V, MIXO, shm); }
    }
}
#undef FA2_BAR0
#undef FA2_BAR3
#undef FA2_SUMPACK
#undef FA2_PV
}
struct Frame {
    LAS unsigned char* lds;
    volatile LAS unsigned* MISC;
    gu32* ctl;
    int tid, lane, wave;
    int vcu, G;
    const float *x, *p; const int* pos;
    const float *attn_norm, *w_in, *w2, *gb, *gon, *qn, *wuq, *kvn, *wukv, *nq, *nk, *w_out, *mlp_norm, *w_up, *w_dn, *ple_norm, *w_g, *b_g, *w_p;
    float* out; unsigned char* ws;
};
__device__ __forceinline__ float wave_sum(float v) {
#pragma unroll
    for (int o = 1; o < 64; o <<= 1) v += __shfl_xor(v, o);
    return v;
}
__device__ __forceinline__ float bflo(unsigned w) { return __uint_as_float(w << 16); }
__device__ __forceinline__ float bfhi(unsigned w) { return __uint_as_float(w & 0xffff0000u); }
__device__ __forceinline__ float logsigmoidf(float y) { return fminf(y, 0.f) - log1pf(__expf(-fabsf(y))); }

__device__ __forceinline__ int zmap(int c) { return c < 1024 ? c : (c < 1952 ? c + 16 : (c < 1968 ? c - 928 : -1)); }
template <bool ZMAP, bool GAIN> __device__ __forceinline__ void p0_transpose_item(const float* W, int K, int Nsrc, int Ndst, const float* gain, bf16* WT, LAS float* scr, int item, int lane) {
    const int nblk = Ndst / 32, kb = item / nblk, nb = item % nblk, k0 = 64 * kb, n0 = 32 * nb;
    const int sc = ZMAP ? zmap(n0 + (lane & 31)) : n0 + (lane & 31);
    const int scc = sc < 0 ? 0 : sc; const float msk = sc < 0 ? 0.f : 1.f;
    float v[32];
#pragma unroll
    for (int i = 0; i < 32; ++i) v[i] = W[(size_t)(k0 + 2 * i + (lane >> 5)) * Nsrc + scc];
    if (GAIN) {
        float g[32];
#pragma unroll
        for (int i = 0; i < 32; ++i) g[i] = gain[k0 + 2 * i + (lane >> 5)];
#pragma unroll
        for (int i = 0; i < 32; ++i) v[i] *= g[i]; }
#pragma unroll
    for (int i = 0; i < 32; ++i) scr[(2 * i + (lane >> 5)) * 33 + (lane & 31)] = v[i] * msk;
    LDS_WAIT(); asm volatile("" ::: "memory");
    const int c = lane & 7;
#pragma unroll
    for (int j = 0; j < 4; ++j) { const int n = (lane >> 3) + 8 * j; const LAS float* s = scr + (8 * c) * 33 + n;
        v4u o; o.x = pk2(s[0 * 33], s[1 * 33]); o.y = pk2(s[2 * 33], s[3 * 33]); o.z = pk2(s[4 * 33], s[5 * 33]); o.w = pk2(s[6 * 33], s[7 * 33]);
        *(GAS v4u*)(WT + (size_t)(n0 + n) * K + k0 + 8 * c) = o; }
    LDS_WAIT(); asm volatile("" ::: "memory");
}
__device__ __forceinline__ void p0_prologue(Frame& F) {
    unsigned char* ws = F.ws;
    if (F.wave >= 4) {
    LAS float* scr = (LAS float*)(F.lds + RING_OFF + F.wave * 16384);
    const int gw = F.vcu * 4 + (F.wave - 4), NGW = F.G * 4;
    constexpr int I_IN = 16 * 64, I_OUT = 16 * 32, I_UP = 16 * 128, I_DN = 64 * 32, I_G = 16 * 32, I_P = 4 * 32;
    constexpr int NITEMS = I_IN + I_OUT + I_UP + I_DN + I_G + I_P;
    for (int it = gw; it < NITEMS; it += NGW) {
        int r = it;
        if (r < I_IN) { p0_transpose_item<true, true>(F.w_in, 1024, 1968, 2048, F.attn_norm, (bf16*)(ws + WS_WIN), scr, r, F.lane); continue; } r -= I_IN;
        if (r < I_OUT) { p0_transpose_item<false, false>(F.w_out, 1024, 1024, 1024, nullptr, (bf16*)(ws + WS_WOUT), scr, r, F.lane); continue; } r -= I_OUT;
        if (r < I_UP) { p0_transpose_item<false, true>(F.w_up, 1024, 4096, 4096, F.mlp_norm, (bf16*)(ws + WS_WUP), scr, r, F.lane); continue; } r -= I_UP;
        if (r < I_DN) { p0_transpose_item<false, false>(F.w_dn, 4096, 1024, 1024, nullptr, (bf16*)(ws + WS_WDN), scr, r, F.lane); continue; } r -= I_DN;
        if (r < I_G) { p0_transpose_item<false, true>(F.w_g, 1024, 1024, 1024, F.ple_norm, (bf16*)(ws + WS_WG), scr, r, F.lane); continue; } r -= I_G;
        p0_transpose_item<false, false>(F.w_p, 256, 1024, 1024, nullptr, (bf16*)(ws + WS_WP), scr, r, F.lane);
    }
    { const int gt = gw * 64 + F.lane, NT = NGW * 64;
      for (int idx = gt; idx < 24576 + 16384; idx += NT) {
        const bool isq = idx < 24576; const int id2 = isq ? idx : idx - 24576; const int f = id2 >> 6, l = id2 & 63, r = l & 31, hi = l >> 5;
        int n, k0, N; const float* W; const float* g;
        if (isq) { const int h = f / 48, nb = (f / 16) % 3, ks = f % 16; n = h * 96 + 32 * nb + r; k0 = 16 * ks + 8 * hi; N = 768; W = F.wuq; g = F.qn; }
        else { const int h = f / 32, nb = (f / 8) % 4, ks = f % 8; n = h * 128 + 32 * nb + r; k0 = 16 * ks + 8 * hi; N = 1024; W = F.wukv; g = F.kvn; }
        float v[8];
#pragma unroll
        for (int j = 0; j < 8; ++j) v[j] = W[(size_t)(k0 + j) * N + n] * g[k0 + j];
        v4u o; o.x = pk2(v[0], v[1]); o.y = pk2(v[2], v[3]); o.z = pk2(v[4], v[5]); o.w = pk2(v[6], v[7]);
        *(GAS v4u*)((isq ? ws + WS_WUQ : ws + WS_WUKV) + (size_t)id2 * 16) = o; } }
    { const int gt = gw * 64 + F.lane, NT = NGW * 64;
      for (int idx = gt; idx < M * 16; idx += NT) { const int m = idx >> 4, i = idx & 15;
        const float invf = exp2f(-(float)(2 * i) * (13.287712379549449f / 32.f));
        const float ang = (float)F.pos[m] * invf;
        double rev = (double)ang * 0.15915494309189535; rev -= rint(rev);
        const float rv = (float)rev;
        float2 cs; cs.x = __builtin_amdgcn_cosf(rv); cs.y = __builtin_amdgcn_sinf(rv);
        ((float2*)(ws + WS_ROPE))[idx] = cs; } }
    } else {
    const int gw = F.vcu * 4 + F.wave, NGW = F.G * 4;
    for (int m0 = gw * 4; m0 < M; m0 += NGW * 4) {
        f32x4 v[4][4]; f32x4 pv[4];
#pragma unroll
        for (int r = 0; r < 4; ++r) { const GAS f32x4* xr = (const GAS f32x4*)(F.x + (size_t)(m0 + r) * DM) + F.lane;
#pragma unroll
            for (int j = 0; j < 4; ++j) v[r][j] = xr[64 * j];
            pv[r] = ((const GAS f32x4*)(F.p + (size_t)(m0 + r) * PLE))[F.lane]; }
#pragma unroll
        for (int r = 0; r < 4; ++r) { const int m = m0 + r; float s = 0.f;
#pragma unroll
            for (int j = 0; j < 4; ++j) s += (v[r][j].x * v[r][j].x + v[r][j].y * v[r][j].y) + (v[r][j].z * v[r][j].z + v[r][j].w * v[r][j].w);
            s = wave_sum(s);
            if (F.lane == 0) ((float*)(ws + WS_RS1))[m] = 1.0f / sqrtf(s * (1.f / DM) + EPS);
            GAS unsigned long long* o8 = (GAS unsigned long long*)((bf16*)(ws + WS_XB) + (size_t)m * DM) + F.lane;
#pragma unroll
            for (int j = 0; j < 4; ++j) o8[64 * j] = (unsigned long long)pk2(v[r][j].x, v[r][j].y) | ((unsigned long long)pk2(v[r][j].z, v[r][j].w) << 32);
            ((GAS unsigned long long*)((bf16*)(ws + WS_PB) + (size_t)m * PLE))[F.lane] = (unsigned long long)pk2(pv[r].x, pv[r].y) | ((unsigned long long)pk2(pv[r].z, pv[r].w) << 32); }
    }
    }
}

struct Args { const void* in[22]; float* out; unsigned char* ws; int ph_lo, ph_hi, li, pad; };
__global__ void __launch_bounds__(NWAVES * 64, 2) fwd(Args args) {
    extern __shared__ __attribute__((aligned(16))) unsigned char lds[];
    Frame F;
    F.lds = (LAS unsigned char*)lds;
    F.MISC = (volatile LAS unsigned*)(F.lds + MISC_OFF);
    F.tid = threadIdx.x; F.lane = F.tid & 63; F.wave = __builtin_amdgcn_readfirstlane(F.tid >> 6);
    F.G = gridDim.x; { const int bx = blockIdx.x; F.vcu = (F.G % 8 == 0) ? (bx % 8) * (F.G / 8) + bx / 8 : bx; }
    unsigned char* ws = args.ws; F.ws = ws;
    F.ctl = (gu32*)(ws + WS_CTL);
    F.x = (const float*)args.in[0]; F.p = (const float*)args.in[1]; F.pos = (const int*)args.in[2]; F.attn_norm = (const float*)args.in[3]; F.w_in = (const float*)args.in[4];
    F.w2 = (const float*)args.in[5]; F.gb = (const float*)args.in[6]; F.gon = (const float*)args.in[7]; F.qn = (const float*)args.in[8]; F.wuq = (const float*)args.in[9];
    F.kvn = (const float*)args.in[10]; F.wukv = (const float*)args.in[11]; F.nq = (const float*)args.in[12]; F.nk = (const float*)args.in[13]; F.w_out = (const float*)args.in[14];
    F.mlp_norm = (const float*)args.in[15]; F.w_up = (const float*)args.in[16]; F.w_dn = (const float*)args.in[17]; F.ple_norm = (const float*)args.in[18]; F.w_g = (const float*)args.in[19];
    F.b_g = (const float*)args.in[20]; F.w_p = (const float*)args.in[21]; F.out = args.out;
    for (int u = F.tid; u < (LDS_BYTES - LDSCTL_OFF) / 4; u += NWAVES * 64) ((LAS unsigned*)(F.lds + LDSCTL_OFF))[u] = 0u;
    __syncthreads();
    XcdBarrier bar; bar.bar = (unsigned*)(F.ctl + CW_BAR); bar.x = 0; bar.st = nullptr;
    if (N_LAUNCHES != NPH) bar = xcd_barrier_post((unsigned*)(F.ctl + CW_BAR), F.MISC + 8);
#define GRID_BAR(seam) do { if (N_LAUNCHES == NPH) { if (F.tid == 0) __hip_atomic_store(F.ctl + CW_TMO, 0xBADBA0u | (unsigned)(seam), RLX_AGENT); } else { xcd_barrier(bar); } } while (0)
    const int lo = args.ph_lo, hi = args.ph_hi;
#define IN(k) (lo <= (k) && (k) < hi)
#define BOTH(k) (IN(k) && IN((k) + 1))
    bf16* XB = (bf16*)(ws + WS_XB); bf16* Z = (bf16*)(ws + WS_Z); bf16* MIX = (bf16*)(ws + WS_MIX); bf16* H1B = (bf16*)(ws + WS_H1B); bf16* H2B = (bf16*)(ws + WS_H2B);
    bf16* HID = (bf16*)(ws + WS_HID); bf16* PB = (bf16*)(ws + WS_PB); bf16* PP = (bf16*)(ws + WS_PP);
    float* SSQ2 = (float*)(ws + WS_CTL + CTL_SSQ2); float* SSQ3 = (float*)(ws + WS_CTL + CTL_SSQ3);
    bf16* QED = (bf16*)((unsigned char*)F.out + OUT_QED); bf16* KED = (bf16*)((unsigned char*)F.out + OUT_KED);

    if (IN(0)) { p0_prologue(F); if (BOTH(0)) GRID_BAR(0); }
    if (IN(1)) {
        pg8::Gemm g{XB, (const bf16*)(ws + WS_WIN), M, ZN, DM}; pg8::StaticOrder S; S.init(M, ZN, F.G, (int)blockIdx.x);
        pg8::EpiBf<0> E{Z, ZW, (const float*)(ws + WS_RS1), ws + WS_LATQ, ws + WS_LATKV};
        pg8::gemm_phase<pg8::EpiBf<0>, pg8::StaticOrder, true, true>(F.lds + RING_OFF, g, S, E);
        if (BOTH(1)) GRID_BAR(1);
    }
    if (IN(2)) {
        prep2::prep_phase(F.vcu, F.G, Z, ws + WS_LATQ, ws + WS_LATKV, ws + WS_WUQ, ws + WS_WUKV, (const prep::f32x2*)(ws + WS_ROPE), F.nq, F.nk, (bf16*)(ws + WS_Q), (bf16*)(ws + WS_K), (bf16*)(ws + WS_V), F.lds + RING_OFF);
        __syncthreads();
        { gla2::G1Ld La, Lb; gla::GateW GW; int u = F.vcu; int hcur_ = -1;
          bf16* USp = (bf16*)(ws + WS_US); float* DECp = (float*)(ws + WS_DEC);
          if (u < 2048) gla2::g1_load(La, u, Z);
          for (; u < 2048; u += 2 * F.G) {
              if (u + F.G < 2048) gla2::g1_load(Lb, u + F.G, Z);
              if (((u >> 5) & 3) != hcur_) { hcur_ = (u >> 5) & 3; gla::gate_load(GW, F.w2, F.gb, hcur_, F.lane); }
              gla2::g1_unit(u, La, GW, USp, DECp, QED, KED, F.lds + RING_OFF);
              if (u + F.G < 2048) { if (u + 2 * F.G < 2048) gla2::g1_load(La, u + 2 * F.G, Z);
                  if ((((u + F.G) >> 5) & 3) != hcur_) { hcur_ = ((u + F.G) >> 5) & 3; gla::gate_load(GW, F.w2, F.gb, hcur_, F.lane); }
                  gla2::g1_unit(u + F.G, Lb, GW, USp, DECp, QED, KED, F.lds + RING_OFF); } } }
        if (BOTH(2)) GRID_BAR(2);
    }
    if (IN(3)) {
        gla::g2_scan((bf16*)(ws + WS_US), (const float*)(ws + WS_DEC), (int)blockIdx.x * 512 + F.tid, F.G * 512);
        fa2::attn_phase(F.vcu, F.G, (const bf16*)(ws + WS_Q), (const bf16*)(ws + WS_K), (const bf16*)(ws + WS_V), MIX, F.lds + RING_OFF);
        if (BOTH(3)) GRID_BAR(3);
    }
    if (IN(4)) {
        { gla2::G3Ld Xa, Xb; int u = F.vcu; const bf16* USc = (const bf16*)(ws + WS_US);
          if (u < 2048) gla2::g3_load(Xa, u, Z, USc, QED, KED);
          for (; u < 2048; u += 2 * F.G) {
              if (u + F.G < 2048) gla2::g3_load(Xb, u + F.G, Z, USc, QED, KED);
              gla2::g3_unit(u, Xa, F.gon, MIX, F.lds + RING_OFF, 0);
              if (u + F.G < 2048) { if (u + 2 * F.G < 2048) gla2::g3_load(Xa, u + 2 * F.G, Z, USc, QED, KED);
                  gla2::g3_unit(u + F.G, Xb, F.gon, MIX, F.lds + RING_OFF, 1); } } }
        if (BOTH(4)) GRID_BAR(4);
    }
    if (IN(5)) {
        { pg8::Gemm g{MIX, (const bf16*)(ws + WS_WOUT), M, DM, DM}; pg8::StaticOrder S; S.init(M, DM, F.G, (int)blockIdx.x);
          pg8::EpiRes3 E{XB, H1B, SSQ2, DM};
          pg8::gemm_phase<pg8::EpiRes3, pg8::StaticOrder, true, true>(F.lds + RING_OFF, g, S, E); }
        { pg8::Gemm g{PB, (const bf16*)(ws + WS_WP), M, DM, PLE}; pg8::StaticOrder S; S.init(M, DM, F.G, (int)blockIdx.x);
          pg8::EpiBf<2> E{PP, DM, nullptr, nullptr, nullptr};
          pg8::gemm_phase<pg8::EpiBf<2>, pg8::StaticOrder, true, true>(F.lds + RING_OFF, g, S, E); }
        if (BOTH(5)) GRID_BAR(5);
    }
    if (IN(6)) {
        pg8::Gemm g{H1B, (const bf16*)(ws + WS_WUP), M, FF, DM}; pg8::StaticOrder S; S.init(M, FF, F.G, (int)blockIdx.x);
        pg8::EpiBf<1> E{HID, FF, SSQ2, nullptr, nullptr};
        pg8::gemm_phase<pg8::EpiBf<1>, pg8::StaticOrder, true, true>(F.lds + RING_OFF, g, S, E);
        if (BOTH(6)) GRID_BAR(6);
    }
    if (IN(7)) {
        pg8::Gemm g{HID, (const bf16*)(ws + WS_WDN), M, DM, FF}; pg8::StaticOrder S; S.init(M, DM, F.G, (int)blockIdx.x);
        pg8::EpiRes3 E{H1B, H2B, SSQ3, DM};
        pg8::gemm_phase<pg8::EpiRes3, pg8::StaticOrder, true, true>(F.lds + RING_OFF, g, S, E);
        if (BOTH(7)) GRID_BAR(7);
    }
    if (IN(8)) {
        pg8::Gemm g{H2B, (const bf16*)(ws + WS_WG), M, DM, DM}; pg8::StaticOrder S; S.init(M, DM, F.G, (int)blockIdx.x);
        pg8::EpiGate3 E{SSQ3, F.b_g, PP, H2B, F.out, DM};
        pg8::gemm_phase<pg8::EpiGate3, pg8::StaticOrder, true, true>(F.lds + RING_OFF, g, S, E);
    }
#undef IN
#undef BOTH
}

extern "C" void kernel_launch(void* const* d_in, const int* in_sizes, int n_in, void* d_out, int out_size, void* d_ws, size_t ws_size, hipStream_t stream) {
    static int grid = 0;
    if (grid == 0) {
        if (n_in != 22 || in_sizes[0] != M * DM || out_size != M * DM || ws_size < WS_END) { fprintf(stderr, "kernel_launch: unexpected shapes (n_in %d, in0 %d, out %d, ws %zu); nothing launched\n", n_in, n_in > 0 ? in_sizes[0] : -1, out_size, ws_size); grid = -1; return; }
        int dev = 0, cus = 0, per_cu = 0;
        if (hipGetDevice(&dev) != hipSuccess || hipDeviceGetAttribute(&cus, hipDeviceAttributeMultiprocessorCount, dev) != hipSuccess) { grid = -1; return; }
        if (hipFuncSetAttribute((const void*)fwd, hipFuncAttributeMaxDynamicSharedMemorySize, LDS_BYTES) != hipSuccess) { fprintf(stderr, "kernel_launch: hipFuncSetAttribute failed\n"); grid = -1; return; }
        if (hipOccupancyMaxActiveBlocksPerMultiprocessor(&per_cu, (const void*)fwd, NWAVES * 64, LDS_BYTES) != hipSuccess || per_cu < 1)
            fprintf(stderr, "kernel_launch: note: occupancy query reports %d workgroups per CU\n", per_cu);
        (void)hipGetLastError();
        grid = cus;
    }
    if (grid < 0) return;
    if (hipMemsetAsync((char*)d_ws + WS_CTL, 0, CTL_ZERO_BYTES, stream) != hipSuccess) { fprintf(stderr, "kernel_launch: hipMemsetAsync failed\n"); return; }
    Args a{};
    for (int i = 0; i < 22; ++i) a.in[i] = d_in[i];
    a.out = (float*)d_out; a.ws = (unsigned char*)d_ws;
    for (int li = 0; li < N_LAUNCHES; ++li) {
        a.ph_lo = (N_LAUNCHES == NPH) ? li : 0; a.ph_hi = (N_LAUNCHES == NPH) ? li + 1 : NPH; a.li = li;
        hipLaunchKernelGGL(fwd, dim3(grid), dim3(NWAVES * 64), LDS_BYTES, stream, a);
        const hipError_t le = hipPeekAtLastError();
        if (le != hipSuccess) { fprintf(stderr, "kernel_launch: launch %d failed: %s\n", li, hipGetErrorName(le)); break; }
    }
}
```

```cpp
#define MK_N_LAUNCHES 1
#include <hip/hip_runtime.h>
#include <cstdio>
#include <cstdint>
namespace pg8 {
#define PG8_LAS __attribute__((address_space(3)))
typedef unsigned short bf16_t;
typedef short bf16x8 __attribute__((ext_vector_type(8)));
typedef float f32x4 __attribute__((ext_vector_type(4)));
typedef unsigned u32x4 __attribute__((ext_vector_type(4)));
constexpr int BM = 256, BK = 64, HALF = 128, HTB = HALF * BK * 2  , STAGE_BYTES = 8 * HTB, NXCD = 8, WGM = 8;

__host__ __device__ __forceinline__ int lds_byte(int r, int c) { const int st = (r >> 4) * 2 + (c >> 5), rr = r & 15, cc = c & 31, ob = rr * 64 + cc * 2; return st * 1024 + (ob ^ (((ob >> 9) & 1) << 5)); }
__host__ __device__ __forceinline__ void stage_rc(int b, int& R, int& C) { const int st = b / 1024, sb = b % 1024, swz = sb ^ (((sb >> 9) & 1) << 5); R = (st >> 1) * 16 + swz / 64; C = (st & 1) * 32 + (swz % 64) / 2; }
__host__ __device__ __forceinline__ int perm32(int rho) { const int n = rho >> 4, i = rho & 15; return 8 * (i >> 2) + 4 * n + (i & 3); }

struct Unit { int pm, pn; };
struct Gemm { const bf16_t* A; const bf16_t* Bt; int M, N, K; };

struct StaticOrder {
    int nM, nN, nwg, G, c;
    __host__ __device__ void init(int M, int N, int G_, int c_) { nM = M / BM; nN = N / BM; nwg = nM * nN; G = G_; c = c_; }
    __host__ __device__ bool next(int i, Unit& u) const {
        const long L = (long)i * G + c; if (L >= nwg) return false;
        int wgid = (int)L; { const int q = nwg / NXCD, r = nwg % NXCD, xcd = wgid % NXCD, off = wgid / NXCD; wgid = (xcd < r ? xcd * (q + 1) : r * (q + 1) + (xcd - r) * q) + off; }
        const int nig = WGM * nN, gid = wgid / nig, fm = gid * WGM, gsz = (nM - fm) < WGM ? (nM - fm) : WGM;
        u.pm = fm + ((wgid % nig) % gsz); u.pn = (wgid % nig) / gsz; return true;
    }
    __device__ __forceinline__ void a_ready(const Unit&) const {}
    __device__ __forceinline__ void done(const Unit&) const {}
};

__device__ __forceinline__ unsigned cvt_pk_bf16(float lo, float hi) { unsigned r; asm volatile("v_cvt_pk_bf16_f32 %0, %1, %2" : "=v"(r) : "v"(lo), "v"(hi)); return r; }
typedef float f32x2 __attribute__((ext_vector_type(2)));
typedef unsigned u32x2 __attribute__((ext_vector_type(2)));
constexpr float RMS_EPS = 1e-6f;
template <int MODE> struct EpiBf {
    static constexpr bool PERM = true, AFTER_DRAIN = false;
    bf16_t* O; int ldc; const float* rs;
    unsigned char* latq; unsigned char* latkv;
    __device__ __forceinline__ void operator()(const f32x4 (&acc)[2][2][4][2], const Unit& u, int wr, int wc, int fr, int fq) const {
        const int row0 = u.pm * BM + wr * 64 + fr, col0 = u.pn * BM + wc * 64 + 8 * fq;
        bool fm[2] = {false, false}; size_t fstride = 0; unsigned char* fb[2] = {nullptr, nullptr};
        if (MODE == 0 && latq) { const int lc = 32 * (fq & 1) * 16;
            if (u.pn == 6) { fm[0] = fm[1] = true; fstride = 16 * 1024; fb[0] = latq + (4 * wc + (fq >> 1)) * 1024 + lc; fb[1] = latq + (4 * wc + 2 + (fq >> 1)) * 1024 + lc; }
            else if (u.pn == 7 && wc < 2) { fm[0] = fm[1] = true; fstride = 8 * 1024; fb[0] = latkv + (4 * wc + (fq >> 1)) * 1024 + lc; fb[1] = latkv + (4 * wc + 2 + (fq >> 1)) * 1024 + lc; } }
#pragma unroll
        for (int ai = 0; ai < 2; ++ai)
#pragma unroll
            for (int m = 0; m < 4; ++m) { const int row = row0 + ai * HALF + m * 16; unsigned char* rowp = (unsigned char*)(O + (size_t)row * ldc + col0);
                float s = 1.f; if (MODE == 0) s = rs[row]; if (MODE == 1) s = __builtin_amdgcn_rsqf(rs[row] * (1.f / 1024.f) + RMS_EPS);
                const size_t foff = (size_t)(row >> 5) * fstride + (size_t)(row & 31) * 16;
#pragma unroll
                for (int bj = 0; bj < 2; ++bj) { f32x4 v0 = acc[ai][bj][m][0] * s, v1 = acc[ai][bj][m][1] * s;
                    if (MODE == 1) {
#pragma unroll
                        for (int e = 0; e < 4; ++e) { const float a = fmaxf(v0[e], 0.f), b = fmaxf(v1[e], 0.f); v0[e] = a * a; v1[e] = b * b; } }
                    u32x4 w; w.x = cvt_pk_bf16(v0[0], v0[1]); w.y = cvt_pk_bf16(v0[2], v0[3]); w.z = cvt_pk_bf16(v1[0], v1[1]); w.w = cvt_pk_bf16(v1[2], v1[3]);
                    unsigned char* dst = (MODE == 0 && fm[bj]) ? fb[bj] + foff : rowp + bj * 32 * 2;
                    *(u32x4*)dst = w; } }
    }
};
struct EpiRes3 {
    static constexpr bool PERM = true, AFTER_DRAIN = false;
    const bf16_t* base; bf16_t* ob; float* ssq; int ldc;
    __device__ __forceinline__ void operator()(const f32x4 (&acc)[2][2][4][2], const Unit& u, int wr, int wc, int fr, int fq) const {
        const int col0 = u.pn * BM + wc * 64 + 8 * fq;
#pragma unroll
        for (int ai = 0; ai < 2; ++ai) {
            u32x4 bw[4][2];
#pragma unroll
            for (int m = 0; m < 4; ++m) { const size_t off = (size_t)(u.pm * BM + ai * HALF + wr * 64 + m * 16 + fr) * ldc + col0;
#pragma unroll
                for (int bj = 0; bj < 2; ++bj) bw[m][bj] = *(const u32x4*)(base + off + bj * 32); }
#pragma unroll
            for (int m = 0; m < 4; ++m) { const int row = u.pm * BM + ai * HALF + wr * 64 + m * 16 + fr; const size_t off = (size_t)row * ldc + col0; float q = 0.f;
#pragma unroll
                for (int bj = 0; bj < 2; ++bj) { const u32x4 w_ = bw[m][bj];
                    f32x4 h0, h1;
                    h0[0] = __uint_as_float(w_.x << 16) + acc[ai][bj][m][0][0]; h0[1] = __uint_as_float(w_.x & 0xffff0000u) + acc[ai][bj][m][0][1]; h0[2] = __uint_as_float(w_.y << 16) + acc[ai][bj][m][0][2]; h0[3] = __uint_as_float(w_.y & 0xffff0000u) + acc[ai][bj][m][0][3];
                    h1[0] = __uint_as_float(w_.z << 16) + acc[ai][bj][m][1][0]; h1[1] = __uint_as_float(w_.z & 0xffff0000u) + acc[ai][bj][m][1][1]; h1[2] = __uint_as_float(w_.w << 16) + acc[ai][bj][m][1][2]; h1[3] = __uint_as_float(w_.w & 0xffff0000u) + acc[ai][bj][m][1][3];
                    q += ((h0[0] * h0[0] + h0[1] * h0[1]) + (h0[2] * h0[2] + h0[3] * h0[3])) + ((h1[0] * h1[0] + h1[1] * h1[1]) + (h1[2] * h1[2] + h1[3] * h1[3]));
                    u32x4 w; w.x = cvt_pk_bf16(h0[0], h0[1]); w.y = cvt_pk_bf16(h0[2], h0[3]); w.z = cvt_pk_bf16(h1[0], h1[1]); w.w = cvt_pk_bf16(h1[2], h1[3]); *(u32x4*)(ob + off + bj * 32) = w; }
                q += __shfl_xor(q, 16); q += __shfl_xor(q, 32);
                if (fq == 0) atomicAdd(ssq + row, q); }
            asm volatile("" ::: "memory"); }
    }
};
struct EpiGate3 {
    static constexpr bool PERM = true, AFTER_DRAIN = false;
    const float* ssq; const float* bias; const bf16_t* pp; const bf16_t* hb; float* out; int ldc;
    __device__ __forceinline__ void operator()(const f32x4 (&acc)[2][2][4][2], const Unit& u, int wr, int wc, int fr, int fq) const {
        const int col0 = u.pn * BM + wc * 64 + 8 * fq;
        f32x4 bv[2][2];
#pragma unroll
        for (int bj = 0; bj < 2; ++bj)
#pragma unroll
            for (int n = 0; n < 2; ++n) bv[bj][n] = *(const f32x4*)(bias + col0 + bj * 32 + n * 4);
#pragma unroll
        for (int ai = 0; ai < 2; ++ai) {
            u32x4 hw[4][2], pw[4][2]; float sq[4];
#pragma unroll
            for (int m = 0; m < 4; ++m) { const int row = u.pm * BM + ai * HALF + wr * 64 + m * 16 + fr; const size_t off = (size_t)row * ldc + col0; sq[m] = ssq[row];
#pragma unroll
                for (int bj = 0; bj < 2; ++bj) { hw[m][bj] = *(const u32x4*)(hb + off + bj * 32); pw[m][bj] = *(const u32x4*)(pp + off + bj * 32); } }
#pragma unroll
            for (int m = 0; m < 4; ++m) { const int row = u.pm * BM + ai * HALF + wr * 64 + m * 16 + fr; const size_t off = (size_t)row * ldc + col0;
                const float s = __builtin_amdgcn_rsqf(sq[m] * (1.f / 1024.f) + RMS_EPS);
#pragma unroll
                for (int bj = 0; bj < 2; ++bj) { const u32x4 h_ = hw[m][bj], p_ = pw[m][bj];
                    const unsigned hh[4] = {h_.x, h_.y, h_.z, h_.w}, ph[4] = {p_.x, p_.y, p_.z, p_.w};
#pragma unroll
                    for (int n = 0; n < 2; ++n) { const f32x4 y = acc[ai][bj][m][n] * s + bv[bj][n]; f32x4 o;
                        const float hv[4] = {__uint_as_float(hh[2 * n] << 16), __uint_as_float(hh[2 * n] & 0xffff0000u), __uint_as_float(hh[2 * n + 1] << 16), __uint_as_float(hh[2 * n + 1] & 0xffff0000u)};
                        const float pf[4] = {__uint_as_float(ph[2 * n] << 16), __uint_as_float(ph[2 * n] & 0xffff0000u), __uint_as_float(ph[2 * n + 1] << 16), __uint_as_float(ph[2 * n + 1] & 0xffff0000u)};
#pragma unroll
                        for (int e = 0; e < 4; ++e) { const float g = __builtin_amdgcn_rcpf(1.f + __builtin_amdgcn_exp2f(-1.4426950408889634f * y[e])); o[e] = hv[e] + pf[e] * g; }
                        *(f32x4*)(out + off + bj * 32 + n * 4) = o; } } }
            asm volatile("" ::: "memory"); }
    }
};
template <class Epi, class Sched, bool ALIGN_EPI = false, bool SP2 = false>
__device__ __forceinline__ void gemm_phase(PG8_LAS unsigned char* lds, const Gemm g, const Sched& S, const Epi& E) {
    const int tid = threadIdx.x, wid = __builtin_amdgcn_readfirstlane(tid >> 6), lane = tid & 63, wr = wid >> 2, wc = wid & 3, fr = lane & 15, fq = lane >> 4;
    const int K = g.K, nt = K / BK;
    unsigned voffA[2], voffB[2];
#pragma unroll
    for (int i = 0; i < 2; ++i) { int R, C; stage_rc(tid * 16 + i * 8192, R, C); const int Rb = Epi::PERM ? (2 * (R & ~31) + perm32(R & 31)) : R;
        voffA[i] = (unsigned)(R * K + C) * 2u; voffB[i] = (unsigned)(Rb * K + C) * 2u; }
    const size_t kstep = (size_t)(BK * 2);
    const size_t hstep = (size_t)HALF * K * 2;
    const size_t tstep = 2 * hstep;
    const size_t hstepB = Epi::PERM ? (size_t)32 * K * 2 : hstep;
    const unsigned ldsw = (unsigned)wid * 1024u;
    const int aoff = lds_byte(wr * 64 + fr, fq * 8), boff = lds_byte(wc * 32 + fr, fq * 8);
#define PG8_SA(b, h) (((b) * 2 + (h)) * HTB)
#define PG8_SB(b, h) ((4 + (b) * 2 + (h)) * HTB)
#define PG8_STAGE(bufoff, gbase, voff) do { _Pragma("unroll") for (int _i = 0; _i < 2; ++_i) \
        __builtin_amdgcn_global_load_lds((const unsigned*)((const char*)(gbase) + (voff)[_i]), (PG8_LAS unsigned*)(lds + (bufoff) + ldsw + _i * 8192), 16, 0, 0); } while (0)
#define PG8_LDA(dst, b, h) do { _Pragma("unroll") for (int m = 0; m < 4; ++m) _Pragma("unroll") for (int k = 0; k < 2; ++k) dst[m][k] = *(const PG8_LAS bf16x8*)(lds + PG8_SA(b, h) + aoff + m * 2048 + k * 1024); } while (0)
#define PG8_LDB(dst, b, h) do { _Pragma("unroll") for (int n = 0; n < 2; ++n) _Pragma("unroll") for (int k = 0; k < 2; ++k) dst[n][k] = *(const PG8_LAS bf16x8*)(lds + PG8_SB(b, h) + boff + n * 2048 + k * 1024); } while (0)
#define PG8_MMA(ai, bj, At, Bt) do { __builtin_amdgcn_s_setprio(1); _Pragma("unroll") for (int m = 0; m < 4; ++m) _Pragma("unroll") for (int n = 0; n < 2; ++n) _Pragma("unroll") for (int k = 0; k < 2; ++k) \
        acc[ai][bj][m][n] = __builtin_amdgcn_mfma_f32_16x16x32_bf16(Bt[n][k], At[m][k], acc[ai][bj][m][n], 0, 0, 0); __builtin_amdgcn_s_setprio(0); } while (0)
#define PG8_WAIT_V(n) asm volatile("s_waitcnt vmcnt(" #n ")" ::: "memory")
#define PG8_WAIT_L(n) asm volatile("s_waitcnt lgkmcnt(" #n ")" ::: "memory")
#define PG8_BAR __builtin_amdgcn_s_barrier()
#define PG8_SCHED __builtin_amdgcn_sched_barrier(0)
    Unit cur, nxt; int ui = 0;
    if (!S.next(0, cur)) return;
    f32x4 acc[2][2][4][2];
#pragma unroll
    for (int a = 0; a < 2; ++a)
#pragma unroll
        for (int b = 0; b < 2; ++b)
#pragma unroll
            for (int m = 0; m < 4; ++m)
#pragma unroll
                for (int n = 0; n < 2; ++n) acc[a][b][m][n] = (f32x4){0.f, 0.f, 0.f, 0.f};
    bf16x8 At[4][2], B0[2][2], B1[2][2];
    const char* cA = (const char*)g.A + (size_t)cur.pm * tstep; const char* cB = (const char*)g.Bt + (size_t)cur.pn * tstep;
    S.a_ready(cur);
    if constexpr (SP2) {
        PG8_STAGE(PG8_SB(0, 0), cB, voffB); PG8_STAGE(PG8_SB(0, 1), cB + hstepB, voffB); PG8_STAGE(PG8_SA(0, 0), cA, voffA); PG8_STAGE(PG8_SA(0, 1), cA + hstep, voffA);
        if (wr == 1) PG8_BAR;
        PG8_WAIT_V(2); PG8_BAR;
        PG8_STAGE(PG8_SB(1, 0), cB + kstep, voffB); PG8_STAGE(PG8_SA(1, 0), cA + kstep, voffA); PG8_STAGE(PG8_SB(1, 1), cB + hstepB + kstep, voffB);
        PG8_WAIT_V(6); PG8_BAR;
    } else {
        PG8_STAGE(PG8_SB(0, 0), cB, voffB); PG8_STAGE(PG8_SA(0, 0), cA, voffA); PG8_STAGE(PG8_SB(0, 1), cB + hstepB, voffB); PG8_STAGE(PG8_SA(0, 1), cA + hstep, voffA);
        if (wr == 1) PG8_BAR;
        PG8_WAIT_V(4); PG8_BAR;
        PG8_STAGE(PG8_SB(1, 0), cB + kstep, voffB); PG8_STAGE(PG8_SA(1, 0), cA + kstep, voffA); PG8_STAGE(PG8_SB(1, 1), cB + hstepB + kstep, voffB);
        PG8_WAIT_V(6); PG8_BAR;
    }
    for (;;) {
        const bool has_next = S.next(ui + 1, nxt);
        const char* nA = has_next ? (const char*)g.A + (size_t)nxt.pm * tstep : cA; const char* nB = has_next ? (const char*)g.Bt + (size_t)nxt.pn * tstep : cB;
        for (int t = 0; t < nt; t += 2) {
            const bool last = (t == nt - 2);
            const char* a1 = cA + (size_t)(t + 1) * kstep;
            const char* a2 = last ? nA : cA + (size_t)(t + 2) * kstep; const char* b2 = last ? nB : cB + (size_t)(t + 2) * kstep;
            const char* a3 = a2 + kstep; const char* b3 = b2 + kstep;
            if (last && has_next) S.a_ready(nxt);
            if constexpr (SP2) {
            PG8_LDB(B0, 0, 0); PG8_LDB(B1, 0, 1); PG8_SCHED; PG8_LDA(At, 0, 0); PG8_STAGE(PG8_SA(1, 1), a1 + hstep, voffA);
            PG8_WAIT_V(8); PG8_WAIT_L(0); PG8_BAR; PG8_MMA(0, 0, At, B0); PG8_MMA(0, 1, At, B1); PG8_BAR; PG8_SCHED;
            PG8_LDA(At, 0, 1); PG8_STAGE(PG8_SB(0, 0), b2, voffB); PG8_STAGE(PG8_SB(0, 1), b2 + hstepB, voffB); PG8_STAGE(PG8_SA(0, 0), a2, voffA);
            PG8_WAIT_V(8); PG8_WAIT_L(0); PG8_BAR; PG8_MMA(1, 0, At, B0); PG8_MMA(1, 1, At, B1); PG8_BAR; PG8_SCHED;
            PG8_LDB(B0, 1, 0); PG8_LDB(B1, 1, 1); PG8_SCHED; PG8_LDA(At, 1, 0); PG8_STAGE(PG8_SA(0, 1), a2 + hstep, voffA);
            PG8_WAIT_V(8); PG8_WAIT_L(0); PG8_BAR; PG8_MMA(0, 0, At, B0); PG8_MMA(0, 1, At, B1); PG8_BAR; PG8_SCHED;
            PG8_LDA(At, 1, 1); PG8_STAGE(PG8_SB(1, 0), b3, voffB); PG8_STAGE(PG8_SB(1, 1), b3 + hstepB, voffB); PG8_STAGE(PG8_SA(1, 0), a3, voffA);
            PG8_WAIT_V(8); PG8_WAIT_L(0); PG8_BAR; PG8_MMA(1, 0, At, B0); PG8_MMA(1, 1, At, B1); PG8_BAR; PG8_SCHED;
            } else {
            PG8_LDB(B0, 0, 0); PG8_SCHED; PG8_LDA(At, 0, 0); PG8_STAGE(PG8_SA(1, 1), a1 + hstep, voffA);
            PG8_WAIT_L(8); PG8_BAR; PG8_WAIT_L(0); PG8_MMA(0, 0, At, B0); PG8_BAR; PG8_SCHED;
            PG8_LDB(B1, 0, 1); PG8_STAGE(PG8_SB(0, 0), b2, voffB);
            PG8_BAR; PG8_WAIT_L(0); PG8_MMA(0, 1, At, B1); PG8_BAR;
            PG8_LDA(At, 0, 1); PG8_STAGE(PG8_SA(0, 0), a2, voffA);
            PG8_BAR; PG8_WAIT_L(0); PG8_MMA(1, 0, At, B0); PG8_BAR; PG8_SCHED;
            PG8_STAGE(PG8_SB(0, 1), b2 + hstepB, voffB);
            PG8_WAIT_V(6); PG8_BAR; PG8_MMA(1, 1, At, B1); PG8_BAR;
            PG8_LDB(B0, 1, 0); PG8_SCHED; PG8_LDA(At, 1, 0); PG8_STAGE(PG8_SA(0, 1), a2 + hstep, voffA);
            PG8_WAIT_L(8); PG8_BAR; PG8_WAIT_L(0); PG8_MMA(0, 0, At, B0); PG8_BAR; PG8_SCHED;
            PG8_LDB(B1, 1, 1); PG8_STAGE(PG8_SB(1, 0), b3, voffB);
            PG8_BAR; PG8_WAIT_L(0); PG8_MMA(0, 1, At, B1); PG8_BAR;
            PG8_LDA(At, 1, 1); PG8_STAGE(PG8_SA(1, 0), a3, voffA);
            PG8_BAR; PG8_WAIT_L(0); PG8_MMA(1, 0, At, B0); PG8_BAR; PG8_SCHED;
            PG8_STAGE(PG8_SB(1, 1), b3 + hstepB, voffB);
            PG8_WAIT_V(6); PG8_BAR; PG8_MMA(1, 1, At, B1); PG8_BAR;
            }
        }
        if constexpr (ALIGN_EPI) { if (wr == 0) PG8_BAR; }
        if constexpr (!Epi::AFTER_DRAIN) { E(acc, cur, wr, wc, fr, fq); S.done(cur); }
        if (!has_next) break;
#pragma unroll
        for (int a = 0; a < 2; ++a)
#pragma unroll
            for (int b = 0; b < 2; ++b)
#pragma unroll
                for (int m = 0; m < 4; ++m)
#pragma unroll
                    for (int n = 0; n < 2; ++n) acc[a][b][m][n] = (f32x4){0.f, 0.f, 0.f, 0.f};
        cur = nxt; cA = nA; cB = nB; ++ui;
        if constexpr (ALIGN_EPI) { if (wr == 1) PG8_BAR; }
    }
    PG8_WAIT_V(0);
    if constexpr (!ALIGN_EPI) { if (wr == 0) PG8_BAR; }
    PG8_BAR;
    if constexpr (Epi::AFTER_DRAIN) { E.fused(acc, cur, wr, wc, fr, fq, lds, wid, lane); S.done(cur); }
#undef PG8_SA
#undef PG8_SB
#undef PG8_STAGE
#undef PG8_LDA
#undef PG8_LDB
#undef PG8_MMA
#undef PG8_WAIT_V
#undef PG8_WAIT_L
#undef PG8_BAR
#undef PG8_SCHED
}
}
constexpr int NWAVES = 8;
#ifndef MK_N_LAUNCHES
#define MK_N_LAUNCHES 1
#endif
constexpr int NPH = 9;
constexpr int N_LAUNCHES = MK_N_LAUNCHES;
constexpr int BATCH = 16, SEQ = 2048, DM = 1024, M = BATCH * SEQ, FF = 4096, PLE = 256, ZN = 2048, ZW = 2112;
constexpr int Z_GQ = 0, Z_GK = 256, Z_GV = 512, Z_GR = 1024, Z_CQ = 1536, Z_CKV = 1792, Z_KR = 1920, Z_GL = 1952;
constexpr int MH = 8, QKD = 96, VD = 64;
constexpr float EPS = 1e-6f;
constexpr float QSCALE = 0.10206207261596577f * 1.4426950408889634f;
constexpr size_t MiB = 1u << 20;
constexpr size_t WS_CTL = 0, CTL_ZERO_BYTES = 1 * MiB;
constexpr size_t CTL_SSQ2 = 256 * 1024, CTL_SSQ3 = 512 * 1024;
constexpr size_t WS_RS1 = 1 * MiB;
constexpr size_t WS_ROPE = 2 * MiB;
constexpr size_t WS_DEC = 6 * MiB;
constexpr size_t WS_WIN = 8 * MiB, WS_WOUT = 12 * MiB, WS_WUP = 14 * MiB, WS_WDN = 22 * MiB, WS_WG = 30 * MiB, WS_WP = 32 * MiB, WS_WUQ = 33 * MiB, WS_WUKV = 34 * MiB;
constexpr size_t WS_PB = 36 * MiB;
constexpr size_t WS_US = 52 * MiB;
constexpr size_t WS_Q = 84 * MiB, WS_K = 132 * MiB, WS_V = 180 * MiB;
constexpr size_t WS_PP = 52 * MiB;
constexpr size_t WS_H1B = 116 * MiB;
constexpr size_t WS_H2B = 180 * MiB;
constexpr size_t WS_LATQ = 212 * MiB, WS_LATKV = 228 * MiB;
constexpr size_t WS_XB = 244 * MiB;
constexpr size_t OUT_QED = 0 * MiB, OUT_KED = 16 * MiB, OUT_VTD = 32 * MiB;
constexpr size_t WS_Z = 308 * MiB;
constexpr size_t WS_MIX = 440 * MiB;
constexpr size_t WS_HID = 244 * MiB;
constexpr size_t WS_END = 504 * MiB;
static_assert(WS_Z + (size_t)M * ZW * 2 <= WS_MIX, "z fits");
constexpr int CW_TMO = 0, CW_CODE = 1, CW_BAR = 4096;
constexpr int RING_OFF = 0, RING_BYTES = 131072;
constexpr int LDSCTL_OFF = RING_BYTES, MISC_OFF = LDSCTL_OFF + 320;
constexpr int LDS_BYTES = 147456;
static_assert(MISC_OFF + 128 <= LDS_BYTES, "LDS map");
#define GAS __attribute__((address_space(1)))
#define LAS __attribute__((address_space(3)))
typedef unsigned short bf16;
typedef unsigned v4u __attribute__((ext_vector_type(4)));
typedef float f32x4 __attribute__((ext_vector_type(4)));
typedef short bf16x8 __attribute__((ext_vector_type(8)));
typedef GAS unsigned gu32;
typedef GAS unsigned long long gu64;
#define RLX_AGENT __ATOMIC_RELAXED, __HIP_MEMORY_SCOPE_AGENT
#define LDS_WAIT() asm volatile("s_waitcnt lgkmcnt(0)" ::: "memory")
#define VM_WAIT() asm volatile("s_waitcnt vmcnt(0)" ::: "memory")
__device__ __forceinline__ unsigned long long rt() { return __builtin_amdgcn_s_memrealtime(); }
__device__ __forceinline__ unsigned f2bf(float f) { unsigned u = __builtin_bit_cast(unsigned, f); return (u + 0x7fffu + ((u >> 16) & 1u)) >> 16; }
__device__ __forceinline__ unsigned pk2(float lo, float hi) { return f2bf(lo) | (f2bf(hi) << 16); }

#define XB_TMO      128
#define XB_XCNT(j)  (256  + 64 * (j))
#define XB_XSUB(j)  (1280 + 64 * (j))
#define XB_XGEN(j)  (2304 + 64 * (j))
#define XB_TOP      3328
#define XB_TOPGEN   3392
#define XCD_BAR_WORDS 3456
#define XB_SPIN_CAP (1u << 18)

__device__ __forceinline__ unsigned xb_ld(unsigned* p)              { return __hip_atomic_load(p, __ATOMIC_RELAXED, __HIP_MEMORY_SCOPE_AGENT); }
__device__ __forceinline__ unsigned xb_add(unsigned* p, unsigned v) { return __hip_atomic_fetch_add(p, v, __ATOMIC_RELAXED, __HIP_MEMORY_SCOPE_AGENT); }
__device__ __forceinline__ unsigned xb_xcc_id() { return (unsigned)__builtin_amdgcn_s_getreg((3 << 11) | 20) & 0xFu; }
#define XB_SPIN(cond, bar) do { unsigned _sp = 0; while (cond) { __builtin_amdgcn_s_sleep(1); \
    if ((++_sp & 255u) == 0u) { if (xb_ld(&(bar)[XB_TMO])) break; if (_sp > XB_SPIN_CAP) { atomicAdd(&(bar)[XB_TMO], 1u); break; } } } } while (0)

struct XcdBarrier {
    unsigned* bar; unsigned x;
    volatile LAS unsigned* st;
};

__device__ __forceinline__ XcdBarrier xcd_barrier_post(unsigned* bar, volatile LAS unsigned* st) {
    XcdBarrier b; b.bar = bar; b.x = xb_xcc_id(); b.st = st;
    if (threadIdx.x == 0) (void)xb_add(&bar[XB_XCNT(b.x)], 1u);
    return b;
}
__device__ __forceinline__ void xcd_barrier_complete(unsigned* bar, unsigned x, unsigned& nloc, unsigned& nx) {
    const unsigned G = gridDim.x * gridDim.y * gridDim.z;
    unsigned sum, cnt, mine, sp = 0u;
    for (;;) {
        sum = 0u; cnt = 0u; mine = 0u;
#pragma unroll
        for (unsigned j = 0; j < 16; ++j) { const unsigned c = xb_ld(&bar[XB_XCNT(j)]); sum += c; cnt += (c > 0u) ? 1u : 0u; mine = (j == x) ? c : mine; }
        if (sum == G) break;
        __builtin_amdgcn_s_sleep(1);
        if ((++sp & 255u) == 0u) { if (xb_ld(&bar[XB_TMO])) break; if (sp > XB_SPIN_CAP) { atomicAdd(&bar[XB_TMO], 1u); break; } }
    }
    nloc = mine > 0u ? mine : 1u; nx = cnt > 0u ? cnt : 1u;
}

__device__ __forceinline__ void xcd_barrier(const XcdBarrier& b) {
    asm volatile("s_waitcnt vmcnt(0)" ::: "memory");
    __syncthreads();
    if (threadIdx.x == 0) {
        unsigned* bar = b.bar;
        __builtin_amdgcn_s_waitcnt(0);
        unsigned nloc = b.st[0], nx = b.st[1];
        if (nloc == 0u) { xcd_barrier_complete(bar, b.x, nloc, nx); b.st[0] = nloc; b.st[1] = nx; }
        const unsigned old = xb_add(&bar[XB_XSUB(b.x)], 1u);
        const unsigned gen = old / nloc;
        if (old + 1u == (gen + 1u) * nloc) {
            __builtin_amdgcn_fence(__ATOMIC_RELEASE, "agent");
            asm volatile("s_waitcnt vmcnt(0)" ::: "memory");
            const unsigned og = xb_add(&bar[XB_TOP], 1u);
            const unsigned tg = og / nx;
            if (og + 1u == (tg + 1u) * nx) xb_add(&bar[XB_TOPGEN], 1u);
            else XB_SPIN(xb_ld(&bar[XB_TOPGEN]) == tg, bar);
            __builtin_amdgcn_fence(__ATOMIC_ACQUIRE, "agent");
            xb_add(&bar[XB_XGEN(b.x)], 1u);
            asm volatile("s_waitcnt vmcnt(0)" ::: "memory");
        } else {
            XB_SPIN(xb_ld(&bar[XB_XGEN(b.x)]) == gen, bar);
            __builtin_amdgcn_fence(__ATOMIC_ACQUIRE, "agent");
            asm volatile("s_waitcnt vmcnt(0)" ::: "memory");
        }
    }
    __syncthreads();
}
__device__ __forceinline__ float bf2f(bf16 h) { return __uint_as_float((unsigned)h << 16); }
namespace fa {
typedef float f32x16 __attribute__((ext_vector_type(16)));
typedef short s16x4 __attribute__((ext_vector_type(4)));
typedef unsigned u32x4 __attribute__((ext_vector_type(4)));
typedef float f32x2_t __attribute__((ext_vector_type(2))); typedef __bf16 bf16x2_t __attribute__((ext_vector_type(2)));
constexpr int KSLOT = 12288, VSLOT = 8192;
constexpr int NSLOT = 4;
constexpr int L_K = 0, L_V = NSLOT * KSLOT, L_WS = L_V + NSLOT * VSLOT, L_OST = L_WS + 8 * 256, L_END = L_OST + 8 * 4096;
static_assert(L_END <= 131072, "attention LDS");
__device__ __forceinline__ int crow(int r, int hi) { return (r & 3) + 8 * (r >> 2) + 4 * hi; }
__device__ __forceinline__ void glds16(const void* gsrc, unsigned lds_dst) { unsigned keep;
    asm volatile("s_mov_b32 %0, m0\n\ts_mov_b32 m0, %2\n\ts_nop 0\n\tglobal_load_lds_dwordx4 %1, off\n\ts_mov_b32 m0, %0" : "=&s"(keep) : "v"(gsrc), "s"(lds_dst) : "memory"); }
__device__ __forceinline__ unsigned cvtpk(float lo, float hi) { f32x2_t v = {lo, hi}; bf16x2_t b = __builtin_convertvector(v, bf16x2_t); return __builtin_bit_cast(unsigned, b); }
__device__ __forceinline__ void pv(f32x16* o, int vb, bf16x8 pa0, bf16x8 pa1, bf16x8 pa2, bf16x8 pa3) {
#pragma unroll
    for (int d0 = 0; d0 < 2; ++d0) { s16x4 lo[4], hi[4];
#pragma unroll
        for (int ks = 0; ks < 4; ++ks) {
            asm volatile("ds_read_b64_tr_b16 %0,%1 offset:%c2" : "=&v"(lo[ks]) : "v"(vb), "i"(d0 * 4096 + ks * 1024) : "memory");
            asm volatile("ds_read_b64_tr_b16 %0,%1 offset:%c2" : "=&v"(hi[ks]) : "v"(vb), "i"(d0 * 4096 + ks * 1024 + 512) : "memory"); }
        asm volatile("s_waitcnt lgkmcnt(0)" ::: "memory"); __builtin_amdgcn_sched_barrier(0);
#define FA_PK(k) (bf16x8){lo[k][0], lo[k][1], lo[k][2], lo[k][3], hi[k][0], hi[k][1], hi[k][2], hi[k][3]}
        o[d0] = __builtin_amdgcn_mfma_f32_32x32x16_bf16(pa0, FA_PK(0), o[d0], 0, 0, 0);
        o[d0] = __builtin_amdgcn_mfma_f32_32x32x16_bf16(pa1, FA_PK(1), o[d0], 0, 0, 0);
        o[d0] = __builtin_amdgcn_mfma_f32_32x32x16_bf16(pa2, FA_PK(2), o[d0], 0, 0, 0);
        o[d0] = __builtin_amdgcn_mfma_f32_32x32x16_bf16(pa3, FA_PK(3), o[d0], 0, 0, 0);
#undef FA_PK
    }
}
}
namespace prep {
typedef float f32x16 __attribute__((ext_vector_type(16)));
typedef unsigned u32x4 __attribute__((ext_vector_type(4)));
typedef unsigned u32x2 __attribute__((ext_vector_type(2)));
typedef float f32x2 __attribute__((ext_vector_type(2)));
__device__ __forceinline__ int crow(int r, int hi) { return (r & 3) + 8 * (r >> 2) + 4 * hi; }
__device__ __forceinline__ float hsum(float v) { auto rr = __builtin_amdgcn_permlane32_swap(__float_as_uint(v), __float_as_uint(v), false, false); return __uint_as_float(rr[0]) + __uint_as_float(rr[1]); }
}
#define LDS_BARRIER() do { asm volatile("s_waitcnt lgkmcnt(0)" ::: "memory"); __builtin_amdgcn_s_barrier(); asm volatile("" ::: "memory"); } while (0)
namespace gla {
typedef float f32x16 __attribute__((ext_vector_type(16)));
typedef unsigned u32x4 __attribute__((ext_vector_type(4)));
typedef unsigned u32x2 __attribute__((ext_vector_type(2)));
typedef short s16x4 __attribute__((ext_vector_type(4)));
__device__ __forceinline__ int crow(int r, int hi) { return (r & 3) + 8 * (r >> 2) + 4 * hi; }
__device__ __forceinline__ float hsum(float v) { auto rr = __builtin_amdgcn_permlane32_swap(__float_as_uint(v), __float_as_uint(v), false, false); return __uint_as_float(rr[0]) + __uint_as_float(rr[1]); }
struct GateW { float w[16]; float bias; };
__device__ __forceinline__ void gate_load(GateW& W, const float* w2, const float* gb, int h, int lane) {
#pragma unroll
    for (int r = 0; r < 16; ++r) W.w[r] = w2[r * 256 + h * 64 + lane];
    W.bias = gb[h * 64 + lane];
}
__device__ __forceinline__ void g2_scan(bf16* US, const float* DEC, int gtid, int gthreads) {
    for (int g = gtid; g < 64 * 128 * 16; g += gthreads) {
        const int kg = g & 15, dv = (g >> 4) & 127, bh = g >> 11;
        float st[4] = {0.f, 0.f, 0.f, 0.f};
#pragma unroll 1
        for (int cb = 0; cb < 4; ++cb) {
            u32x2 uv[8]; f32x4 dc[8];
#pragma unroll
            for (int i = 0; i < 8; ++i) { const int c = cb * 8 + i; uv[i] = *(const u32x2*)(US + ((size_t)(bh * 32 + c) * 128 + dv) * 64 + kg * 4); dc[i] = *(const f32x4*)(DEC + (size_t)(bh * 32 + c) * 64 + kg * 4); }
#pragma unroll
            for (int i = 0; i < 8; ++i) { const int c = cb * 8 + i; u32x2 o; o.x = pk2(st[0], st[1]); o.y = pk2(st[2], st[3]);
                *(u32x2*)(US + ((size_t)(bh * 32 + c) * 128 + dv) * 64 + kg * 4) = o;
                st[0] = st[0] * dc[i][0] + __uint_as_float(uv[i].x << 16); st[1] = st[1] * dc[i][1] + __uint_as_float(uv[i].x & 0xffff0000u);
                st[2] = st[2] * dc[i][2] + __uint_as_float(uv[i].y << 16); st[3] = st[3] * dc[i][3] + __uint_as_float(uv[i].y & 0xffff0000u); }
        }
    }
}
}
namespace gla2 {
using gla::f32x16; using gla::u32x4; using gla::u32x2; using gla::s16x4; using gla::crow; using gla::hsum; using gla::GateW; using gla::gate_load;
constexpr int ST = 144, VS = 320;
constexpr int L_SEG = 0, L_V = 2048, L_KR = L_V + 64 * VS, L_QR = L_KR + 64 * ST, L_KD = L_QR + 64 * ST, L_QE = L_KD + 64 * ST, L_KE = L_QE + 64 * ST, L_END = L_KE + 64 * ST;
constexpr int G3_QE = 0, G3_KE = 64 * ST, G3_V = 2 * 64 * ST, G3_RED = G3_V + 64 * VS, G3_END = G3_RED + 1024, G3_BUF = 40960;
static_assert(G3_END <= G3_BUF && L_END <= 131072, "gla2 LDS");
__device__ __forceinline__ s16x4 trr(int addr, int off) { s16x4 r; asm volatile("ds_read_b64_tr_b16 %0,%1 offset:%c2" : "=&v"(r) : "v"(addr), "i"(off) : "memory"); return r; }
struct G1Ld { unsigned g2; u32x4 k, q, v0, v1; };
__device__ __forceinline__ void g1_load(G1Ld& L, int u, const bf16* z) {
    const int tid = threadIdx.x, lane = tid & 63; const int wv = __builtin_amdgcn_readfirstlane(tid >> 6);
    const int bh = u >> 5, c = u & 31, b = bh >> 2, h = bh & 3, row0 = b * SEQ + 64 * c;
    L.g2 = *(const unsigned*)(z + (size_t)(row0 + 8 * wv + (lane >> 3)) * ZW + Z_GL + (lane & 7) * 2);
    const bf16* zr = z + (size_t)(row0 + (tid >> 3)) * ZW;
    L.k = *(const u32x4*)(zr + Z_GK + h * 64 + (tid & 7) * 8); L.q = *(const u32x4*)(zr + Z_GQ + h * 64 + (tid & 7) * 8);
    const bf16* zv = z + (size_t)(row0 + (tid >> 4)) * ZW + Z_GV + h * 128 + (tid & 15) * 8;
    L.v0 = *(const u32x4*)zv; L.v1 = *(const u32x4*)(zv + (size_t)32 * ZW);
}
__device__ __forceinline__ void g1_unit(int u, const G1Ld& L, const GateW& W, bf16* US, float* DEC, bf16* QED, bf16* KED, LAS unsigned char* shm) {
    const int tid = threadIdx.x, lane = tid & 63, r32 = lane & 31, hi = lane >> 5; const int wv = __builtin_amdgcn_readfirstlane(tid >> 6);
    const int bh = u >> 5, c = u & 31;
    *(LAS u32x4*)(shm + L_KR + (tid >> 3) * ST + (tid & 7) * 16) = L.k; *(LAS u32x4*)(shm + L_QR + (tid >> 3) * ST + (tid & 7) * 16) = L.q;
    *(LAS u32x4*)(shm + L_V + (tid >> 4) * VS + (tid & 15) * 16) = L.v0; *(LAS u32x4*)(shm + L_V + (32 + (tid >> 4)) * VS + (tid & 15) * 16) = L.v1;
    float bc[8]; float run = 0.f;
#pragma unroll
    for (int i = 0; i < 8; ++i) { float y = W.bias;
#pragma unroll
        for (int r2 = 0; r2 < 8; ++r2) { const unsigned gw = (unsigned)__builtin_amdgcn_readlane((int)L.g2, i * 8 + r2); y += __uint_as_float(gw << 16) * W.w[2 * r2] + __uint_as_float(gw & 0xffff0000u) * W.w[2 * r2 + 1]; }
        const float la = (fminf(y, 0.f) - __logf(1.f + __expf(-fabsf(y)))) * (1.f / 16.f);
        run += la; bc[i] = run; }
    LAS float* segt = (LAS float*)(shm + L_SEG);
    segt[wv * 64 + lane] = run;
    LDS_BARRIER();
    { float pre = 0.f, tot = 0.f;
#pragma unroll
      for (int s = 0; s < 8; ++s) { const float v = segt[s * 64 + lane]; tot += v; if (s < wv) pre += v; }
      const LAS bf16* kr = (const LAS bf16*)(shm + L_KR) + (8 * wv) * (ST / 2) + lane; const LAS bf16* qr = (const LAS bf16*)(shm + L_QR) + (8 * wv) * (ST / 2) + lane;
      LAS bf16* qe = (LAS bf16*)(shm + L_QE) + (8 * wv) * (ST / 2) + lane; LAS bf16* ke = (LAS bf16*)(shm + L_KE) + (8 * wv) * (ST / 2) + lane;
      float kd[8];
#pragma unroll
      for (int i = 0; i < 8; ++i) { const float bci = bc[i] + pre; const float kv = bf2f(kr[i * (ST / 2)]), qv = bf2f(qr[i * (ST / 2)]); const float e = __expf(bci);
          kd[i] = kv * __expf(tot - bci); qe[i * (ST / 2)] = (bf16)f2bf(qv * 0.125f * e); ke[i * (ST / 2)] = (bf16)f2bf(kv * __builtin_amdgcn_rcpf(e)); }
      u32x4 o; o.x = pg8::cvt_pk_bf16(kd[0], kd[1]); o.y = pg8::cvt_pk_bf16(kd[2], kd[3]); o.z = pg8::cvt_pk_bf16(kd[4], kd[5]); o.w = pg8::cvt_pk_bf16(kd[6], kd[7]);
      *(LAS u32x4*)(shm + L_KD + lane * ST + wv * 16) = o;
      if (wv == 0) DEC[(size_t)(bh * 32 + c) * 64 + lane] = __expf(tot); }
    LDS_BARRIER();
    { const int dvb = wv >> 1, kb = wv & 1; f32x16 acc = f32x16{};
      const int va = (int)(unsigned)(uintptr_t)(shm + L_V) + (8 * hi + ((lane & 15) >> 2)) * VS + (32 * dvb + 16 * ((lane >> 4) & 1) + 4 * (lane & 3)) * 2;
      s16x4 lo[4], h4[4];
#pragma unroll
      for (int ks = 0; ks < 4; ++ks) { lo[ks] = trr(va, ks * 16 * VS); h4[ks] = trr(va, ks * 16 * VS + 4 * VS); }
      asm volatile("s_waitcnt lgkmcnt(0)" ::: "memory"); __builtin_amdgcn_sched_barrier(0);
      bf16x8 bb[4];
#pragma unroll
      for (int ks = 0; ks < 4; ++ks) bb[ks] = *(const LAS bf16x8*)(shm + L_KD + (32 * kb + r32) * ST + ks * 32 + hi * 16);
      asm volatile("s_waitcnt lgkmcnt(0)" ::: "memory"); __builtin_amdgcn_sched_barrier(0);
#pragma unroll
      for (int ks = 0; ks < 4; ++ks) { const bf16x8 a = (bf16x8){lo[ks][0], lo[ks][1], lo[ks][2], lo[ks][3], h4[ks][0], h4[ks][1], h4[ks][2], h4[ks][3]};
          acc = __builtin_amdgcn_mfma_f32_32x32x16_bf16(bb[ks], a, acc, 0, 0, 0); }
      const u32x4 qd = *(const LAS u32x4*)(shm + L_QE + (tid >> 3) * ST + (tid & 7) * 16), kdd = *(const LAS u32x4*)(shm + L_KE + (tid >> 3) * ST + (tid & 7) * 16);
      *(u32x4*)(QED + (size_t)u * 4096 + tid * 8) = qd; *(u32x4*)(KED + (size_t)u * 4096 + tid * 8) = kdd;
      bf16* up = US + ((size_t)(bh * 32 + c) * 128 + 32 * dvb + r32) * 64 + 32 * kb + 4 * hi;
#pragma unroll
      for (int g = 0; g < 4; ++g) { u32x2 ow; ow.x = fa::cvtpk(acc[4 * g], acc[4 * g + 1]); ow.y = fa::cvtpk(acc[4 * g + 2], acc[4 * g + 3]); *(u32x2*)(up + 8 * g) = ow; } }
    LDS_BARRIER();
}
struct G3Ld { u32x4 q, k, v0, v1; bf16x8 sfr[4]; u32x2 grw[4]; };
__device__ __forceinline__ void g3_load(G3Ld& X, int u, const bf16* z, const bf16* US, const bf16* QED, const bf16* KED) {
    const int tid = threadIdx.x, lane = tid & 63, r32 = lane & 31, hi = lane >> 5; const int wv = __builtin_amdgcn_readfirstlane(tid >> 6);
    const int bh = u >> 5, c = u & 31, b = bh >> 2, h = bh & 3, row0 = b * SEQ + 64 * c;
    const int dvb = wv >> 1, tb = wv & 1;
    X.q = *(const u32x4*)(QED + (size_t)u * 4096 + tid * 8); X.k = *(const u32x4*)(KED + (size_t)u * 4096 + tid * 8);
    const bf16* zv = z + (size_t)(row0 + (tid >> 4)) * ZW + Z_GV + h * 128 + (tid & 15) * 8;
    X.v0 = *(const u32x4*)zv; X.v1 = *(const u32x4*)(zv + (size_t)32 * ZW);
    { const bf16* sp = US + ((size_t)(bh * 32 + c) * 128 + 32 * dvb + r32) * 64 + hi * 8;
#pragma unroll
      for (int ks = 0; ks < 4; ++ks) X.sfr[ks] = *(const bf16x8*)(sp + ks * 16); }
    { const bf16* gr = z + (size_t)(row0 + 32 * tb + r32) * ZW + Z_GR + h * 128 + 32 * dvb + 4 * hi;
#pragma unroll
      for (int g = 0; g < 4; ++g) X.grw[g] = *(const u32x2*)(gr + 8 * g); }
}
__device__ __forceinline__ void g3_unit(int u, const G3Ld& X, const float* gon, bf16* MIXO, LAS unsigned char* shm0, int buf) {
    const int tid = threadIdx.x, lane = tid & 63, r32 = lane & 31, hi = lane >> 5; const int wv = __builtin_amdgcn_readfirstlane(tid >> 6);
    const int bh = u >> 5, c = u & 31, b = bh >> 2, h = bh & 3, row0 = b * SEQ + 64 * c;
    const int dvb = wv >> 1, tb = wv & 1;
    LAS unsigned char* shm = shm0 + buf * G3_BUF;
    f32x4 gnv[4];
#pragma unroll
    for (int g = 0; g < 4; ++g) gnv[g] = *(const f32x4*)(gon + 32 * dvb + 8 * g + 4 * hi);
    *(LAS u32x4*)(shm + G3_QE + (tid >> 3) * ST + (tid & 7) * 16) = X.q; *(LAS u32x4*)(shm + G3_KE + (tid >> 3) * ST + (tid & 7) * 16) = X.k;
    *(LAS u32x4*)(shm + G3_V + (tid >> 4) * VS + (tid & 15) * 16) = X.v0; *(LAS u32x4*)(shm + G3_V + (32 + (tid >> 4)) * VS + (tid & 15) * 16) = X.v1;
    LDS_BARRIER();
    f32x16 o = f32x16{};
    bf16x8 qf[4];
#pragma unroll
    for (int ks = 0; ks < 4; ++ks) qf[ks] = *(const LAS bf16x8*)(shm + G3_QE + (32 * tb + r32) * ST + ks * 32 + hi * 16);
    const int va = (int)(unsigned)(uintptr_t)(shm + G3_V) + (4 * hi + ((lane & 15) >> 2)) * VS + (32 * dvb + 16 * ((lane >> 4) & 1) + 4 * (lane & 3)) * 2;
    s16x4 vl[4], vh[4];
#pragma unroll
    for (int j = 0; j < 4; ++j) { if ((j >> 1) <= tb) { vl[j] = trr(va, j * 16 * VS); vh[j] = trr(va, j * 16 * VS + 8 * VS); } else { vl[j] = s16x4{}; vh[j] = s16x4{}; } }
    asm volatile("s_waitcnt lgkmcnt(0)" ::: "memory"); __builtin_amdgcn_sched_barrier(0);
#pragma unroll
    for (int ks = 0; ks < 4; ++ks) o = __builtin_amdgcn_mfma_f32_32x32x16_bf16(X.sfr[ks], qf[ks], o, 0, 0, 0);
    asm volatile("s_waitcnt lgkmcnt(0)" ::: "memory"); __builtin_amdgcn_sched_barrier(0);
#pragma unroll
    for (int sb = 0; sb < 2; ++sb) {
        if (sb <= tb) {
            f32x16 sc = f32x16{};
#pragma unroll
            for (int ks = 0; ks < 4; ++ks) { const bf16x8 a = *(const LAS bf16x8*)(shm + G3_KE + (32 * sb + r32) * ST + ks * 32 + hi * 16); sc = __builtin_amdgcn_mfma_f32_32x32x16_bf16(a, qf[ks], sc, 0, 0, 0); }
            if (sb == tb) {
#pragma unroll
                for (int r = 0; r < 16; ++r) sc[r] = (crow(r, hi) <= r32) ? sc[r] : 0.f; }
#pragma unroll
            for (int kk = 0; kk < 2; ++kk) { const int j = sb * 2 + kk;
                u32x4 pw; pw.x = fa::cvtpk(sc[8 * kk], sc[8 * kk + 1]); pw.y = fa::cvtpk(sc[8 * kk + 2], sc[8 * kk + 3]); pw.z = fa::cvtpk(sc[8 * kk + 4], sc[8 * kk + 5]); pw.w = fa::cvtpk(sc[8 * kk + 6], sc[8 * kk + 7]);
                const bf16x8 av = (bf16x8){vl[j][0], vl[j][1], vl[j][2], vl[j][3], vh[j][0], vh[j][1], vh[j][2], vh[j][3]};
                o = __builtin_amdgcn_mfma_f32_32x32x16_bf16(av, __builtin_bit_cast(bf16x8, pw), o, 0, 0, 0); }
        }
    }
    { float ss = 0.f;
#pragma unroll
      for (int r = 0; r < 16; ++r) ss += o[r] * o[r];
      ss = hsum(ss);
      LAS float* red = (LAS float*)(shm + G3_RED);
      if (hi == 0) red[dvb * 64 + 32 * tb + r32] = ss;
      LDS_BARRIER();
      const int t = 32 * tb + r32;
      const float tot = (red[t] + red[64 + t]) + (red[128 + t] + red[192 + t]);
      const float rn = __builtin_amdgcn_rsqf(tot * (1.f / 128.f) + EPS);
      bf16* mp = MIXO + (size_t)(row0 + t) * DM + h * 128 + 32 * dvb + 4 * hi;
#pragma unroll
      for (int g = 0; g < 4; ++g) { const u32x2 gw = X.grw[g]; const f32x4 gn = gnv[g];
          float gv[4] = {__uint_as_float(gw.x << 16), __uint_as_float(gw.x & 0xffff0000u), __uint_as_float(gw.y << 16), __uint_as_float(gw.y & 0xffff0000u)}; float v[4];
#pragma unroll
          for (int e = 0; e < 4; ++e) { const float sl = gv[e] * __builtin_amdgcn_rcpf(1.f + __expf(-gv[e])); v[e] = o[4 * g + e] * rn * gn[e] * sl; }
          u32x2 ow; ow.x = pg8::cvt_pk_bf16(v[0], v[1]); ow.y = pg8::cvt_pk_bf16(v[2], v[3]); *(u32x2*)(mp + 8 * g) = ow; } }
}
}
namespace prep2 {
using prep::f32x16; using prep::u32x4; using prep::u32x2; using prep::f32x2; using prep::crow; using prep::hsum;
constexpr int L_WQ = 0, L_WKV = 49152, L_STG = 81920  , L_G = 132096  , QROW = 192;
static_assert(L_STG + 8 * 6144 <= 131072 && L_G + 768 <= LDS_BYTES && 32 * QROW <= 6144, "prep2 LDS");
__device__ __forceinline__ float sumsq8(const u32x4 w) { const float a0 = __uint_as_float(w.x << 16), a1 = __uint_as_float(w.x & 0xffff0000u), a2 = __uint_as_float(w.y << 16), a3 = __uint_as_float(w.y & 0xffff0000u),
    a4 = __uint_as_float(w.z << 16), a5 = __uint_as_float(w.z & 0xffff0000u), a6 = __uint_as_float(w.w << 16), a7 = __uint_as_float(w.w & 0xffff0000u);
    return ((a0 * a0 + a1 * a1) + (a2 * a2 + a3 * a3)) + ((a4 * a4 + a5 * a5) + (a6 * a6 + a7 * a7)); }
template <int ABL = 0> __device__ __forceinline__ void prep_phase(int vcu, int G, const bf16* z, const unsigned char* latq, const unsigned char* latkv, const unsigned char* wuqf, const unsigned char* wukvf, const f32x2* rope, const float* nq, const float* nk, bf16* Q, bf16* K, bf16* V, LAS unsigned char* shm) {
    const int tid = threadIdx.x, lane = tid & 63, r32 = lane & 31, hi = lane >> 5; const int wv = __builtin_amdgcn_readfirstlane(tid >> 6);
    for (int u = vcu; u < 256; u += G) {
        const int h = u & 7, rc = u >> 3;
        { const u32x4* sq = (const u32x4*)(wuqf + (size_t)h * 49152); const u32x4* sk = (const u32x4*)(wukvf + (size_t)h * 32768);
#pragma unroll
          for (int i = 0; i < 6; ++i) *(LAS u32x4*)(shm + L_WQ + (i * 512 + tid) * 16) = sq[i * 512 + tid];
#pragma unroll
          for (int i = 0; i < 4; ++i) *(LAS u32x4*)(shm + L_WKV + (i * 512 + tid) * 16) = sk[i * 512 + tid];
          if (tid < 96) ((LAS float*)(shm + L_G))[tid] = nq[tid]; else if (tid < 192) ((LAS float*)(shm + L_G))[tid] = nk[tid - 96]; }
        __syncthreads();
        const LAS float* gq = (const LAS float*)(shm + L_G); const LAS float* gk = gq + 96;
        LAS unsigned char* stg = shm + L_STG + wv * 6144;
        const unsigned char* lqb = latq + (size_t)rc * (32 * 16384); const unsigned char* lkb = latkv + (size_t)rc * (32 * 8192);
#pragma unroll 1
        for (int bi = wv; bi < 32; bi += 8) {
            const int row = rc * 1024 + bi * 32 + r32, b = row >> 11, s = row & 2047;
            const bf16* zr = z + (size_t)row * ZW;
            u32x4 cq[16], ckv[8]; u32x2 krw[4]; u32x4 rp[4];
#pragma unroll
            for (int ks = 0; ks < 16; ++ks) cq[ks] = *(const u32x4*)(lqb + (unsigned)(bi * 16384 + ks * 1024 + lane * 16));
            { const u32x4* rr = (const u32x4*)(rope + (size_t)row * 16); rp[0] = rr[2 * hi]; rp[1] = rr[2 * hi + 1]; rp[2] = rr[4 + 2 * hi]; rp[3] = rr[4 + 2 * hi + 1]; }
            float ssq = 0.f, sskv = 0.f;
#pragma unroll
            for (int ks = 0; ks < 16; ++ks) ssq += sumsq8(cq[ks]);
            const float rq = __builtin_amdgcn_rsqf(hsum(ssq) * (1.f / 256.f) + EPS);
            float cs[8], sn[8];
#pragma unroll
            for (int j = 0; j < 4; ++j) { const int a = j >> 1; const bool odd = j & 1;
                cs[j] = __uint_as_float(odd ? rp[a].z : rp[a].x); sn[j] = __uint_as_float(odd ? rp[a].w : rp[a].y);
                cs[4 + j] = __uint_as_float(odd ? rp[2 + a].z : rp[2 + a].x); sn[4 + j] = __uint_as_float(odd ? rp[2 + a].w : rp[2 + a].y); }
            { f32x16 acc[3]; acc[0] = f32x16{}; acc[1] = f32x16{}; acc[2] = f32x16{};
#pragma unroll
              for (int ks = 0; ks < 16; ++ks)
#pragma unroll
                  for (int nb = 0; nb < 3; ++nb) { const bf16x8 a = *(const LAS bf16x8*)(shm + L_WQ + ((nb * 16 + ks) * 64 + lane) * 16);
                      if (!(ABL & 1)) acc[nb] = __builtin_amdgcn_mfma_f32_32x32x16_bf16(a, __builtin_bit_cast(bf16x8, cq[ks]), acc[nb], 0, 0, 0); else asm volatile("" :: "v"(a), "v"(cq[ks])); }
#pragma unroll
              for (int ks = 0; ks < 8; ++ks) ckv[ks] = *(const u32x4*)(lkb + (unsigned)(bi * 8192 + ks * 1024 + lane * 16));
#pragma unroll
              for (int g = 0; g < 4; ++g) krw[g] = *(const u32x2*)(zr + Z_KR + 8 * g + 4 * hi);
              float ss = 0.f;
#pragma unroll
              for (int nb = 0; nb < 3; ++nb)
#pragma unroll
                  for (int r = 0; r < 16; ++r) ss += acc[nb][r] * acc[nb][r];
              ss = hsum(ss) * rq * rq; const float sc = __builtin_amdgcn_rsqf(ss * (1.f / 96.f) + EPS) * rq * QSCALE;
#pragma unroll
              for (int nb = 0; nb < 3; ++nb) { float v[16];
#pragma unroll
                  for (int r = 0; r < 16; ++r) v[r] = acc[nb][r] * sc * gq[32 * nb + crow(r, hi)];
                  if (nb == 2) {
#pragma unroll
                      for (int r = 0; r < 8; ++r) { const float x1 = v[r], x2 = v[r + 8]; v[r] = x1 * cs[r] - x2 * sn[r]; v[r + 8] = x2 * cs[r] + x1 * sn[r]; } }
#pragma unroll
                  for (int g = 0; g < 4; ++g) { u32x2 o; o.x = pg8::cvt_pk_bf16(v[4 * g], v[4 * g + 1]); o.y = pg8::cvt_pk_bf16(v[4 * g + 2], v[4 * g + 3]); *(LAS u32x2*)(stg + r32 * QROW + (32 * nb + 8 * g + 4 * hi) * 2) = o; } }
              asm volatile("s_waitcnt lgkmcnt(0)" ::: "memory");
              bf16* qb = Q + ((size_t)(b * MH + h) * SEQ + (s - r32)) * QKD;
#pragma unroll
              for (int j = 0; j < 6; ++j) { const int i = lane + 64 * j, t = i / 12, c = i - 12 * t; const u32x4 w = *(const LAS u32x4*)(stg + t * QROW + c * 16); if (!(ABL & 2)) *(u32x4*)(qb + i * 8) = w; else asm volatile("" :: "v"(w)); }
              asm volatile("s_waitcnt lgkmcnt(0)" ::: "memory"); }
#pragma unroll
            for (int ks = 0; ks < 8; ++ks) sskv += sumsq8(ckv[ks]);
            const float rkv = __builtin_amdgcn_rsqf(hsum(sskv) * (1.f / 128.f) + EPS);
            { f32x16 acc[2]; acc[0] = f32x16{}; acc[1] = f32x16{};
#pragma unroll
              for (int ks = 0; ks < 8; ++ks)
#pragma unroll
                  for (int nb = 0; nb < 2; ++nb) { const bf16x8 a = *(const LAS bf16x8*)(shm + L_WKV + ((nb * 8 + ks) * 64 + lane) * 16);
                      if (!(ABL & 1)) acc[nb] = __builtin_amdgcn_mfma_f32_32x32x16_bf16(a, __builtin_bit_cast(bf16x8, ckv[ks]), acc[nb], 0, 0, 0); else asm volatile("" :: "v"(a), "v"(ckv[ks])); }
              float kr[16]; float ss = 0.f, sk = 0.f;
#pragma unroll
              for (int g = 0; g < 4; ++g) { kr[4 * g] = __uint_as_float(krw[g].x << 16); kr[4 * g + 1] = __uint_as_float(krw[g].x & 0xffff0000u); kr[4 * g + 2] = __uint_as_float(krw[g].y << 16); kr[4 * g + 3] = __uint_as_float(krw[g].y & 0xffff0000u); }
#pragma unroll
              for (int r = 0; r < 16; ++r) sk += kr[r] * kr[r];
#pragma unroll
              for (int nb = 0; nb < 2; ++nb)
#pragma unroll
                  for (int r = 0; r < 16; ++r) ss += acc[nb][r] * acc[nb][r];
              ss = hsum(ss * rkv * rkv + sk); const float rk = __builtin_amdgcn_rsqf(ss * (1.f / 96.f) + EPS);
              bf16* kp = K + ((size_t)(b * MH + h) * 32 + (s >> 6)) * (12 * 64 * 8) + (s & 63) * 8;
#pragma unroll
              for (int nb = 0; nb < 3; ++nb) { float v[16];
                  if (nb < 2) {
#pragma unroll
                      for (int r = 0; r < 16; ++r) v[r] = acc[nb < 2 ? nb : 0][r] * (rk * rkv) * gk[32 * nb + crow(r, hi)];
                  } else {
#pragma unroll
                      for (int r = 0; r < 16; ++r) v[r] = kr[r] * rk * gk[64 + crow(r, hi)];
#pragma unroll
                      for (int r = 0; r < 8; ++r) { const float x1 = v[r], x2 = v[r + 8]; v[r] = x1 * cs[r] - x2 * sn[r]; v[r + 8] = x2 * cs[r] + x1 * sn[r]; } }
#pragma unroll
                  for (int g = 0; g < 4; ++g) { u32x2 o; o.x = pg8::cvt_pk_bf16(v[4 * g], v[4 * g + 1]); o.y = pg8::cvt_pk_bf16(v[4 * g + 2], v[4 * g + 3]); if (!(ABL & 2)) *(u32x2*)(kp + (4 * nb + g) * 512 + 4 * hi) = o; else asm volatile("" :: "v"(o)); } } }
            { f32x16 acc[2]; acc[0] = f32x16{}; acc[1] = f32x16{};
#pragma unroll
              for (int ks = 0; ks < 8; ++ks)
#pragma unroll
                  for (int nb = 0; nb < 2; ++nb) { const bf16x8 a = *(const LAS bf16x8*)(shm + L_WKV + (((2 + nb) * 8 + ks) * 64 + lane) * 16);
                      if (!(ABL & 1)) acc[nb] = __builtin_amdgcn_mfma_f32_32x32x16_bf16(a, __builtin_bit_cast(bf16x8, ckv[ks]), acc[nb], 0, 0, 0); else asm volatile("" :: "v"(a), "v"(ckv[ks])); }
#pragma unroll
              for (int nb = 0; nb < 2; ++nb)
#pragma unroll
                  for (int g = 0; g < 4; ++g) { u32x2 o; o.x = pg8::cvt_pk_bf16(acc[nb][4 * g] * rkv, acc[nb][4 * g + 1] * rkv); o.y = pg8::cvt_pk_bf16(acc[nb][4 * g + 2] * rkv, acc[nb][4 * g + 3] * rkv);
                      *(LAS u32x2*)(stg + ((nb * 2 + (r32 >> 4)) * 16 + (r32 & 15)) * 64 + (8 * g + 4 * hi) * 2) = o; }
              asm volatile("s_waitcnt lgkmcnt(0)" ::: "memory");
              bf16* vt = V + ((size_t)(b * MH + h) * 32 + (s >> 6)) * 4096 + (((s - r32) & 63) >> 4) * 512;
#pragma unroll
              for (int pc = 0; pc < 4; ++pc) { const u32x4 w = *(const LAS u32x4*)(stg + pc * 1024 + lane * 16); if (!(ABL & 2)) *(u32x4*)(vt + (pc >> 1) * 2048 + (pc & 1) * 512 + lane * 8) = w; else asm volatile("" :: "v"(w)); }
              asm volatile("s_waitcnt lgkmcnt(0)" ::: "memory"); }
        }
        __syncthreads();
    }
}
}
namespace fa2 {
using namespace fa;
__device__ __forceinline__ float max3f(float a, float b, float c) { float r; asm("v_max3_f32 %0, %1, %2, %3" : "=v"(r) : "v"(a), "v"(b), "v"(c)); return r; }
__device__ __forceinline__ float max2f(float a, float b) { float r; asm("v_max_f32_e32 %0, %1, %2" : "=v"(r) : "v"(a), "v"(b)); return r; }
__device__ __forceinline__ void glds16s(unsigned voff, const void* sbase, unsigned lds_dst) { unsigned keep;
    asm volatile("s_mov_b32 %0, m0\n\ts_mov_b32 m0, %2\n\ts_nop 0\n\tglobal_load_lds_dwordx4 %1, %3\n\ts_mov_b32 m0, %0" : "=&s"(keep) : "v"(voff), "s"(lds_dst), "s"(sbase) : "memory"); }
__device__ __forceinline__ void qkt2(f32x16& p0, f32x16& p1, const LAS unsigned char* Kslot, const bf16x8* qr, const f32x16& negm, int r32, int hi) {
    const LAS unsigned char* kb = Kslot + hi * 1024 + r32 * 16;
#pragma unroll
    for (int d0 = 0; d0 < 6; ++d0) {
        const bf16x8 b0 = *(const LAS bf16x8*)(kb + d0 * 2048);
        const bf16x8 b1 = *(const LAS bf16x8*)(kb + d0 * 2048 + 512);
        if (d0 == 0) { p0 = __builtin_amdgcn_mfma_f32_32x32x16_bf16(b0, qr[0], negm, 0, 0, 0); p1 = __builtin_amdgcn_mfma_f32_32x32x16_bf16(b1, qr[0], negm, 0, 0, 0); }
        else { p0 = __builtin_amdgcn_mfma_f32_32x32x16_bf16(b0, qr[d0], p0, 0, 0, 0); p1 = __builtin_amdgcn_mfma_f32_32x32x16_bf16(b1, qr[d0], p1, 0, 0, 0); } }
}
__device__ __forceinline__ float rowmax2(const f32x16& p0, const f32x16& p1) {
    float a = max3f(p0[0], p0[1], p1[0]), b = max3f(p0[2], p0[3], p1[1]); a = max3f(a, p1[2], p1[3]);
#pragma unroll
    for (int r = 4; r < 16; r += 4) { a = max3f(a, p0[r], p0[r + 1]); b = max3f(b, p0[r + 2], p0[r + 3]); a = max3f(a, p1[r], p1[r + 1]); b = max3f(b, p1[r + 2], p1[r + 3]); }
    const float m = max2f(a, b);
    auto rr = __builtin_amdgcn_permlane32_swap(__float_as_uint(m), __float_as_uint(m), false, false);
    return max2f(__uint_as_float(rr[0]), __uint_as_float(rr[1]));
}
#define FA2_BAR0() asm volatile("s_waitcnt vmcnt(0) lgkmcnt(0)\n\ts_barrier" ::: "memory")
#define FA2_BAR3() asm volatile("s_waitcnt vmcnt(3) lgkmcnt(0)\n\ts_barrier" ::: "memory")
#define FA2_SUMPACK(P0, P1) do { float s_ = 0.f; _Pragma("unroll") for (int r = 0; r < 16; ++r) s_ += P0[r] + P1[r]; l += s_; \
    pw0 = (u32x4){cvtpk(P0[0], P0[1]), cvtpk(P0[2], P0[3]), cvtpk(P0[4], P0[5]), cvtpk(P0[6], P0[7])}; \
    pw1 = (u32x4){cvtpk(P0[8], P0[9]), cvtpk(P0[10], P0[11]), cvtpk(P0[12], P0[13]), cvtpk(P0[14], P0[15])}; \
    pw2 = (u32x4){cvtpk(P1[0], P1[1]), cvtpk(P1[2], P1[3]), cvtpk(P1[4], P1[5]), cvtpk(P1[6], P1[7])}; \
    pw3 = (u32x4){cvtpk(P1[8], P1[9]), cvtpk(P1[10], P1[11]), cvtpk(P1[12], P1[13]), cvtpk(P1[14], P1[15])}; } while (0)
#define FA2_PV(slot) pv(o, vb0 + (slot) * VSLOT, __builtin_bit_cast(bf16x8, pw0), __builtin_bit_cast(bf16x8, pw1), __builtin_bit_cast(bf16x8, pw2), __builtin_bit_cast(bf16x8, pw3))
template <int THR, int ABL = 0> __device__ __forceinline__ void attn_unit2(int bh, int qb, const bf16* Q, const bf16* K, const bf16* V, bf16* MIXO, LAS unsigned char* shm) {
    const int tid = threadIdx.x, lane = tid & 63, r32 = lane & 31, hi = lane >> 5; const int wid = __builtin_amdgcn_readfirstlane(tid >> 6);
    const int b = bh >> 3, h = bh & 7, q0 = qb * 256;
    const bf16* Qw = Q + ((size_t)bh * 2048 + q0 + wid * 32) * 96;
    const bf16* Kh = K + (size_t)bh * 32 * (12 * 64 * 8); const bf16* Vh = V + (size_t)bh * 32 * 4096;
    const unsigned lds0 = (unsigned)(uintptr_t)shm;
    LAS float* wsf = (LAS float*)(shm + L_WS) + wid * 64;
    const int c1 = wid, c2 = 8 + (wid & 3);
    const bf16* ksrc1 = Kh + c1 * 512; const bf16* ksrc2 = Kh + c2 * 512; const bf16* vsrc = Vh + wid * 512;
    const unsigned voff = (unsigned)lane * 16u;
    const unsigned kdst1 = lds0 + L_K + c1 * 1024, kdst2 = lds0 + L_K + c2 * 1024, vdst = lds0 + L_V + wid * 1024;
#define FA2_DMA(t) do { const int t_ = (t); const int sl_ = t_ & 3; glds16s(voff, ksrc1 + (size_t)t_ * (12 * 64 * 8), (unsigned)__builtin_amdgcn_readfirstlane(kdst1 + sl_ * KSLOT)); \
        glds16s(voff, ksrc2 + (size_t)t_ * (12 * 64 * 8), (unsigned)__builtin_amdgcn_readfirstlane(kdst2 + sl_ * KSLOT)); \
        glds16s(voff, vsrc + (size_t)t_ * 4096, (unsigned)__builtin_amdgcn_readfirstlane(vdst + sl_ * VSLOT)); } while (0)
    const int vb0 = (int)(lds0 + L_V) + ((lane >> 4) & 1) * 32 + (lane & 3) * 8 + (4 * hi + ((lane & 15) >> 2)) * 64;
    const int NT = 4 * qb + 4, tw = 4 * qb + (wid >> 1);
    FA2_DMA(0); FA2_DMA(1);
    bf16x8 qr[6];
#pragma unroll
    for (int d0 = 0; d0 < 6; ++d0) qr[d0] = *(const bf16x8*)(Qw + (size_t)r32 * 96 + d0 * 16 + hi * 8);
#pragma unroll
    for (int d0 = 0; d0 < 6; ++d0) asm volatile("" : "+v"(qr[d0]));
    float mhat = 0.f, l = 0.f; f32x16 o[2]; o[0] = f32x16{}; o[1] = f32x16{}; f32x16 negm = f32x16{}; asm volatile("" : "+v"(negm));
    u32x4 pw0, pw1, pw2, pw3;
    FA2_BAR0();
    FA2_DMA(2);
    { f32x16 c0, c1; qkt2(c0, c1, shm + L_K, qr, negm, r32, hi); asm volatile("s_nop 15\n\ts_nop 7" : "+v"(c0), "+v"(c1));
      const float rm = rowmax2(c0, c1); mhat = rm;
#pragma unroll
      for (int r = 0; r < 16; ++r) { c0[r] = __builtin_amdgcn_exp2f(c0[r] - rm); c1[r] = __builtin_amdgcn_exp2f(c1[r] - rm); }
#pragma unroll
      for (int r = 0; r < 16; ++r) negm[r] = -mhat;
      asm volatile("" : "+v"(negm));
      FA2_SUMPACK(c0, c1); }
    FA2_BAR3();
    for (int t = 1; t < NT; ++t) {
        if (!(ABL & 1)) FA2_DMA((t + 2 < NT) ? t + 2 : NT - 1);
        if (t <= tw + 1) {
            f32x16 c0, c1; bool resc = false;
            if (t <= tw) { qkt2(c0, c1, shm + L_K + (t & 3) * KSLOT, qr, negm, r32, hi); asm volatile("s_nop 15\n\ts_nop 7" : "+v"(c0), "+v"(c1)); }
            else {
#pragma unroll
                for (int r = 0; r < 16; ++r) { c0[r] = -INFINITY; c1[r] = -INFINITY; }
                asm volatile("" : "+v"(c0), "+v"(c1)); }
            const float rm = rowmax2(c0, c1);
            if (__any(rm > (float)THR)) { const float dl = fmaxf(rm, 0.f); mhat += dl;
#pragma unroll
                for (int r = 0; r < 16; ++r) { c0[r] -= dl; c1[r] -= dl; }
#pragma unroll
                for (int r = 0; r < 16; ++r) negm[r] = -mhat;
                asm volatile("" : "+v"(negm));
                const float f = __builtin_amdgcn_exp2f(-dl); l *= f; if (hi == 0) wsf[r32] = f; resc = true; }
            { const int vb = vb0 + ((t - 1) & 3) * VSLOT; s16x4 vl[8], vh[8];
#pragma unroll
              for (int i = 0; i < 8; ++i) {
                  asm volatile("ds_read_b64_tr_b16 %0,%1 offset:%c2" : "=&v"(vl[i]) : "v"(vb), "i"((i >> 2) * 4096 + (i & 3) * 1024) : "memory");
                  asm volatile("ds_read_b64_tr_b16 %0,%1 offset:%c2" : "=&v"(vh[i]) : "v"(vb), "i"((i >> 2) * 4096 + (i & 3) * 1024 + 512) : "memory"); }
              asm volatile("s_waitcnt lgkmcnt(0)" ::: "memory"); __builtin_amdgcn_sched_barrier(0);
#define FA2_VF(i) (bf16x8){vl[i][0], vl[i][1], vl[i][2], vl[i][3], vh[i][0], vh[i][1], vh[i][2], vh[i][3]}
#define FA2_GAP(D, KS, PW, X, B) do { if (!(ABL & 8)) o[D] = __builtin_amdgcn_mfma_f32_32x32x16_bf16(__builtin_bit_cast(bf16x8, PW), FA2_VF((D) * 4 + (KS)), o[D], 0, 0, 0); else asm volatile("" :: "v"(vl[(D) * 4 + (KS)]), "v"(vh[(D) * 4 + (KS)]), "v"(PW)); \
              if (!(ABL & 2)) { X[B] = __builtin_amdgcn_exp2f(X[B]); X[B + 1] = __builtin_amdgcn_exp2f(X[B + 1]); X[B + 2] = __builtin_amdgcn_exp2f(X[B + 2]); X[B + 3] = __builtin_amdgcn_exp2f(X[B + 3]); } \
              asm volatile("" : "+v"(X)); __builtin_amdgcn_sched_barrier(0); } while (0)
              FA2_GAP(0, 0, pw0, c0, 0); FA2_GAP(1, 0, pw0, c0, 4); FA2_GAP(0, 1, pw1, c0, 8); FA2_GAP(1, 1, pw1, c0, 12);
              FA2_GAP(0, 2, pw2, c1, 0); FA2_GAP(1, 2, pw2, c1, 4); FA2_GAP(0, 3, pw3, c1, 8); FA2_GAP(1, 3, pw3, c1, 12);
#undef FA2_GAP
#undef FA2_VF
            }
            FA2_SUMPACK(c0, c1);
            if (resc) {
#pragma unroll
                for (int r = 0; r < 16; ++r) { const float fr = wsf[crow(r, hi)]; o[0][r] *= fr; o[1][r] *= fr; } }
        }
        if (!(ABL & 16)) FA2_BAR3(); else asm volatile("s_waitcnt lgkmcnt(0)" ::: "memory");
    }
    if (tw == NT - 1) { FA2_PV(tw & 3); }
    { auto rr = __builtin_amdgcn_permlane32_swap(__float_as_uint(l), __float_as_uint(l), false, false); l = __uint_as_float(rr[0]) + __uint_as_float(rr[1]); }
    if (hi == 0) wsf[32 + r32] = l;
    float rli[16];
#pragma unroll
    for (int r = 0; r < 16; ++r) rli[r] = __builtin_amdgcn_rcpf(wsf[32 + crow(r, hi)]);
    bf16* Ow = MIXO + ((size_t)b * 2048 + q0 + wid * 32) * 1024 + 512 + h * 64;
    { LAS bf16* stg = (LAS bf16*)(shm + L_OST) + wid * 2048;
#pragma unroll
      for (int r = 0; r < 16; ++r) { const int orow = crow(r, hi);
#pragma unroll
          for (int d0 = 0; d0 < 2; ++d0) stg[orow * 64 + d0 * 32 + r32] = (bf16)f2bf(o[d0][r] * rli[r]); }
      asm volatile("s_waitcnt lgkmcnt(0)" ::: "memory");
#pragma unroll
      for (int i = 0; i < 4; ++i) { const int row = i * 8 + (lane >> 3), ch = lane & 7; const u32x4 v = *(const LAS u32x4*)(stg + row * 64 + ch * 8); *(u32x4*)(Ow + (size_t)row * 1024 + ch * 8) = v; } }
    FA2_BAR0();
#undef FA2_DMA
}
#ifndef ATTN_THR
#define ATTN_THR 8
#endif
template <int ABL = 0> __device__ __forceinline__ void attn_phase(int vcu, int G, const bf16* Q, const bf16* K, const bf16* V, bf16* MIXO, LAS unsigned char* shm) {
    for (int u = vcu; u < 256; u += G) {
        const int bh = u >> 1, half = u & 1;
#pragma unroll 1
        for (int i = 0; i < 4; ++i) { const int qb = half ? (i == 0 ? 6 : i == 1 ? 1 : i == 2 ? 4 : 3) : (i == 0 ? 7 : i == 1 ? 0 : i == 2 ? 5 : 2); attn_unit2<ATTN_THR, ABL>(bh, qb, Q, K, V, MIXO, shm); }
    }
}
#undef FA2_BAR0
#undef FA2_BAR3
#undef FA2_SUMPACK
#undef FA2_PV
}
struct Frame {
    LAS unsigned char* lds;
    volatile LAS unsigned* MISC;
    gu32* ctl;
    int tid, lane, wave;
    int vcu, G;
    const float *x, *p; const int* pos;
    const float *attn_norm, *w_in, *w2, *gb, *gon, *qn, *wuq, *kvn, *wukv, *nq, *nk, *w_out, *mlp_norm, *w_up, *w_dn, *ple_norm, *w_g, *b_g, *w_p;
    float* out; unsigned char* ws;
};
__device__ __forceinline__ float wave_sum(float v) {
#pragma unroll
    for (int o = 1; o < 64; o <<= 1) v += __shfl_xor(v, o);
    return v;
}
__device__ __forceinline__ float bflo(unsigned w) { return __uint_as_float(w << 16); }
__device__ __forceinline__ float bfhi(unsigned w) { return __uint_as_float(w & 0xffff0000u); }
__device__ __forceinline__ float logsigmoidf(float y) { return fminf(y, 0.f) - log1pf(__expf(-fabsf(y))); }

__device__ __forceinline__ int zmap(int c) { return c < 1024 ? c : (c < 1952 ? c + 16 : (c < 1968 ? c - 928 : -1)); }
template <bool ZMAP, bool GAIN> __device__ __forceinline__ void p0_transpose_item(const float* W, int K, int Nsrc, int Ndst, const float* gain, bf16* WT, LAS float* scr, int item, int lane) {
    const int nblk = Ndst / 32, kb = item / nblk, nb = item % nblk, k0 = 64 * kb, n0 = 32 * nb;
    const int sc = ZMAP ? zmap(n0 + (lane & 31)) : n0 + (lane & 31);
    const int scc = sc < 0 ? 0 : sc; const float msk = sc < 0 ? 0.f : 1.f;
    float v[32];
#pragma unroll
    for (int i = 0; i < 32; ++i) v[i] = W[(size_t)(k0 + 2 * i + (lane >> 5)) * Nsrc + scc];
    if (GAIN) {
        float g[32];
#pragma unroll
        for (int i = 0; i < 32; ++i) g[i] = gain[k0 + 2 * i + (lane >> 5)];
#pragma unroll
        for (int i = 0; i < 32; ++i) v[i] *= g[i]; }
#pragma unroll
    for (int i = 0; i < 32; ++i) scr[(2 * i + (lane >> 5)) * 33 + (lane & 31)] = v[i] * msk;
    LDS_WAIT(); asm volatile("" ::: "memory");
    const int c = lane & 7;
#pragma unroll
    for (int j = 0; j < 4; ++j) { const int n = (lane >> 3) + 8 * j; const LAS float* s = scr + (8 * c) * 33 + n;
        v4u o; o.x = pk2(s[0 * 33], s[1 * 33]); o.y = pk2(s[2 * 33], s[3 * 33]); o.z = pk2(s[4 * 33], s[5 * 33]); o.w = pk2(s[6 * 33], s[7 * 33]);
        *(GAS v4u*)(WT + (size_t)(n0 + n) * K + k0 + 8 * c) = o; }
    LDS_WAIT(); asm volatile("" ::: "memory");
}
__device__ __forceinline__ void p0_prologue(Frame& F) {
    unsigned char* ws = F.ws;
    if (F.wave >= 4) {
    LAS float* scr = (LAS float*)(F.lds + RING_OFF + F.wave * 16384);
    const int gw = F.vcu * 4 + (F.wave - 4), NGW = F.G * 4;
    constexpr int I_IN = 16 * 64, I_OUT = 16 * 32, I_UP = 16 * 128, I_DN = 64 * 32, I_G = 16 * 32, I_P = 4 * 32;
    constexpr int NITEMS = I_IN + I_OUT + I_UP + I_DN + I_G + I_P;
    for (int it = gw; it < NITEMS; it += NGW) {
        int r = it;
        if (r < I_IN) { p0_transpose_item<true, true>(F.w_in, 1024, 1968, 2048, F.attn_norm, (bf16*)(ws + WS_WIN), scr, r, F.lane); continue; } r -= I_IN;
        if (r < I_OUT) { p0_transpose_item<false, false>(F.w_out, 1024, 1024, 1024, nullptr, (bf16*)(ws + WS_WOUT), scr, r, F.lane); continue; } r -= I_OUT;
        if (r < I_UP) { p0_transpose_item<false, true>(F.w_up, 1024, 4096, 4096, F.mlp_norm, (bf16*)(ws + WS_WUP), scr, r, F.lane); continue; } r -= I_UP;
        if (r < I_DN) { p0_transpose_item<false, false>(F.w_dn, 4096, 1024, 1024, nullptr, (bf16*)(ws + WS_WDN), scr, r, F.lane); continue; } r -= I_DN;
        if (r < I_G) { p0_transpose_item<false, true>(F.w_g, 1024, 1024, 1024, F.ple_norm, (bf16*)(ws + WS_WG), scr, r, F.lane); continue; } r -= I_G;
        p0_transpose_item<false, false>(F.w_p, 256, 1024, 1024, nullptr, (bf16*)(ws + WS_WP), scr, r, F.lane);
    }
    { const int gt = gw * 64 + F.lane, NT = NGW * 64;
      for (int idx = gt; idx < 24576 + 16384; idx += NT) {
        const bool isq = idx < 24576; const int id2 = isq ? idx : idx - 24576; const int f = id2 >> 6, l = id2 & 63, r = l & 31, hi = l >> 5;
        int n, k0, N; const float* W; const float* g;
        if (isq) { const int h = f / 48, nb = (f / 16) % 3, ks = f % 16; n = h * 96 + 32 * nb + r; k0 = 16 * ks + 8 * hi; N = 768; W = F.wuq; g = F.qn; }
        else { const int h = f / 32, nb = (f / 8) % 4, ks = f % 8; n = h * 128 + 32 * nb + r; k0 = 16 * ks + 8 * hi; N = 1024; W = F.wukv; g = F.kvn; }
        float v[8];
#pragma unroll
        for (int j = 0; j < 8; ++j) v[j] = W[(size_t)(k0 + j) * N + n] * g[k0 + j];
        v4u o; o.x = pk2(v[0], v[1]); o.y = pk2(v[2], v[3]); o.z = pk2(v[4], v[5]); o.w = pk2(v[6], v[7]);
        *(GAS v4u*)((isq ? ws + WS_WUQ : ws + WS_WUKV) + (size_t)id2 * 16) = o; } }
    { const int gt = gw * 64 + F.lane, NT = NGW * 64;
      for (int idx = gt; idx < M * 16; idx += NT) { const int m = idx >> 4, i = idx & 15;
        const float invf = exp2f(-(float)(2 * i) * (13.287712379549449f / 32.f));
        const float ang = (float)F.pos[m] * invf;
        double rev = (double)ang * 0.15915494309189535; rev -= rint(rev);
        const float rv = (float)rev;
        float2 cs; cs.x = __builtin_amdgcn_cosf(rv); cs.y = __builtin_amdgcn_sinf(rv);
        ((float2*)(ws + WS_ROPE))[idx] = cs; } }
    } else {
    const int gw = F.vcu * 4 + F.wave, NGW = F.G * 4;
    for (int m0 = gw * 4; m0 < M; m0 += NGW * 4) {
        f32x4 v[4][4]; f32x4 pv[4];
#pragma unroll
        for (int r = 0; r < 4; ++r) { const GAS f32x4* xr = (const GAS f32x4*)(F.x + (size_t)(m0 + r) * DM) + F.lane;
#pragma unroll
            for (int j = 0; j < 4; ++j) v[r][j] = xr[64 * j];
            pv[r] = ((const GAS f32x4*)(F.p + (size_t)(m0 + r) * PLE))[F.lane]; }
#pragma unroll
        for (int r = 0; r < 4; ++r) { const int m = m0 + r; float s = 0.f;
#pragma unroll
            for (int j = 0; j < 4; ++j) s += (v[r][j].x * v[r][j].x + v[r][j].y * v[r][j].y) + (v[r][j].z * v[r][j].z + v[r][j].w * v[r][j].w);
            s = wave_sum(s);
            if (F.lane == 0) ((float*)(ws + WS_RS1))[m] = 1.0f / sqrtf(s * (1.f / DM) + EPS);
            GAS unsigned long long* o8 = (GAS unsigned long long*)((bf16*)(ws + WS_XB) + (size_t)m * DM) + F.lane;
#pragma unroll
            for (int j = 0; j < 4; ++j) o8[64 * j] = (unsigned long long)pk2(v[r][j].x, v[r][j].y) | ((unsigned long long)pk2(v[r][j].z, v[r][j].w) << 32);
            ((GAS unsigned long long*)((bf16*)(ws + WS_PB) + (size_t)m * PLE))[F.lane] = (unsigned long long)pk2(pv[r].x, pv[r].y) | ((unsigned long long)pk2(pv[r].z, pv[r].w) << 32); }
    }
    }
}

struct Args { const void* in[22]; float* out; unsigned char* ws; int ph_lo, ph_hi, li, pad; };
__global__ void __launch_bounds__(NWAVES * 64, 2) fwd(Args args) {
    extern __shared__ __attribute__((aligned(16))) unsigned char lds[];
    Frame F;
    F.lds = (LAS unsigned char*)lds;
    F.MISC = (volatile LAS unsigned*)(F.lds + MISC_OFF);
    F.tid = threadIdx.x; F.lane = F.tid & 63; F.wave = __builtin_amdgcn_readfirstlane(F.tid >> 6);
    F.G = gridDim.x; { const int bx = blockIdx.x; F.vcu = (F.G % 8 == 0) ? (bx % 8) * (F.G / 8) + bx / 8 : bx; }
    unsigned char* ws = args.ws; F.ws = ws;
    F.ctl = (gu32*)(ws + WS_CTL);
    F.x = (const float*)args.in[0]; F.p = (const float*)args.in[1]; F.pos = (const int*)args.in[2]; F.attn_norm = (const float*)args.in[3]; F.w_in = (const float*)args.in[4];
    F.w2 = (const float*)args.in[5]; F.gb = (const float*)args.in[6]; F.gon = (const float*)args.in[7]; F.qn = (const float*)args.in[8]; F.wuq = (const float*)args.in[9];
    F.kvn = (const float*)args.in[10]; F.wukv = (const float*)args.in[11]; F.nq = (const float*)args.in[12]; F.nk = (const float*)args.in[13]; F.w_out = (const float*)args.in[14];
    F.mlp_norm = (const float*)args.in[15]; F.w_up = (const float*)args.in[16]; F.w_dn = (const float*)args.in[17]; F.ple_norm = (const float*)args.in[18]; F.w_g = (const float*)args.in[19];
    F.b_g = (const float*)args.in[20]; F.w_p = (const float*)args.in[21]; F.out = args.out;
    for (int u = F.tid; u < (LDS_BYTES - LDSCTL_OFF) / 4; u += NWAVES * 64) ((LAS unsigned*)(F.lds + LDSCTL_OFF))[u] = 0u;
    __syncthreads();
    XcdBarrier bar; bar.bar = (unsigned*)(F.ctl + CW_BAR); bar.x = 0; bar.st = nullptr;
    if (N_LAUNCHES != NPH) bar = xcd_barrier_post((unsigned*)(F.ctl + CW_BAR), F.MISC + 8);
#define GRID_BAR(seam) do { if (N_LAUNCHES == NPH) { if (F.tid == 0) __hip_atomic_store(F.ctl + CW_TMO, 0xBADBA0u | (unsigned)(seam), RLX_AGENT); } else { xcd_barrier(bar); } } while (0)
    const int lo = args.ph_lo, hi = args.ph_hi;
#define IN(k) (lo <= (k) && (k) < hi)
#define BOTH(k) (IN(k) && IN((k) + 1))
    bf16* XB = (bf16*)(ws + WS_XB); bf16* Z = (bf16*)(ws + WS_Z); bf16* MIX = (bf16*)(ws + WS_MIX); bf16* H1B = (bf16*)(ws + WS_H1B); bf16* H2B = (bf16*)(ws + WS_H2B);
    bf16* HID = (bf16*)(ws + WS_HID); bf16* PB = (bf16*)(ws + WS_PB); bf16* PP = (bf16*)(ws + WS_PP);
    float* SSQ2 = (float*)(ws + WS_CTL + CTL_SSQ2); float* SSQ3 = (float*)(ws + WS_CTL + CTL_SSQ3);
    bf16* QED = (bf16*)((unsigned char*)F.out + OUT_QED); bf16* KED = (bf16*)((unsigned char*)F.out + OUT_KED);

    if (IN(0)) { p0_prologue(F); if (BOTH(0)) GRID_BAR(0); }
    if (IN(1)) {
        pg8::Gemm g{XB, (const bf16*)(ws + WS_WIN), M, ZN, DM}; pg8::StaticOrder S; S.init(M, ZN, F.G, (int)blockIdx.x);
        pg8::EpiBf<0> E{Z, ZW, (const float*)(ws + WS_RS1), ws + WS_LATQ, ws + WS_LATKV};
        pg8::gemm_phase<pg8::EpiBf<0>, pg8::StaticOrder, true, true>(F.lds + RING_OFF, g, S, E);
        if (BOTH(1)) GRID_BAR(1);
    }
    if (IN(2)) {
        prep2::prep_phase(F.vcu, F.G, Z, ws + WS_LATQ, ws + WS_LATKV, ws + WS_WUQ, ws + WS_WUKV, (const prep::f32x2*)(ws + WS_ROPE), F.nq, F.nk, (bf16*)(ws + WS_Q), (bf16*)(ws + WS_K), (bf16*)(ws + WS_V), F.lds + RING_OFF);
        __syncthreads();
        { gla2::G1Ld La, Lb; gla::GateW GW; int u = F.vcu; int hcur_ = -1;
          bf16* USp = (bf16*)(ws + WS_US); float* DECp = (float*)(ws + WS_DEC);
          if (u < 2048) gla2::g1_load(La, u, Z);
          for (; u < 2048; u += 2 * F.G) {
              if (u + F.G < 2048) gla2::g1_load(Lb, u + F.G, Z);
              if (((u >> 5) & 3) != hcur_) { hcur_ = (u >> 5) & 3; gla::gate_load(GW, F.w2, F.gb, hcur_, F.lane); }
              gla2::g1_unit(u, La, GW, USp, DECp, QED, KED, F.lds + RING_OFF);
              if (u + F.G < 2048) { if (u + 2 * F.G < 2048) gla2::g1_load(La, u + 2 * F.G, Z);
                  if ((((u + F.G) >> 5) & 3) != hcur_) { hcur_ = ((u + F.G) >> 5) & 3; gla::gate_load(GW, F.w2, F.gb, hcur_, F.lane); }
                  gla2::g1_unit(u + F.G, Lb, GW, USp, DECp, QED, KED, F.lds + RING_OFF); } } }
        if (BOTH(2)) GRID_BAR(2);
    }
    if (IN(3)) {
        gla::g2_scan((bf16*)(ws + WS_US), (const float*)(ws + WS_DEC), (int)blockIdx.x * 512 + F.tid, F.G * 512);
        fa2::attn_phase(F.vcu, F.G, (const bf16*)(ws + WS_Q), (const bf16*)(ws + WS_K), (const bf16*)(ws + WS_V), MIX, F.lds + RING_OFF);
        if (BOTH(3)) GRID_BAR(3);
    }
    if (IN(4)) {
        { gla2::G3Ld Xa, Xb; int u = F.vcu; const bf16* USc = (const bf16*)(ws + WS_US);
          if (u < 2048) gla2::g3_load(Xa, u, Z, USc, QED, KED);
          for (; u < 2048; u += 2 * F.G) {
              if (u + F.G < 2048) gla2::g3_load(Xb, u + F.G, Z, USc, QED, KED);
              gla2::g3_unit(u, Xa, F.gon, MIX, F.lds + RING_OFF, 0);
              if (u + F.G < 2048) { if (u + 2 * F.G < 2048) gla2::g3_load(Xa, u + 2 * F.G, Z, USc, QED, KED);
                  gla2::g3_unit(u + F.G, Xb, F.gon, MIX, F.lds + RING_OFF, 1); } } }
        if (BOTH(4)) GRID_BAR(4);
    }
    if (IN(5)) {
        { pg8::Gemm g{MIX, (const bf16*)(ws + WS_WOUT), M, DM, DM}; pg8::StaticOrder S; S.init(M, DM, F.G, (int)blockIdx.x);
          pg8::EpiRes3 E{XB, H1B, SSQ2, DM};
          pg8::gemm_phase<pg8::EpiRes3, pg8::StaticOrder, true, true>(F.lds + RING_OFF, g, S, E); }
        if (BOTH(5)) GRID_BAR(5);
    }
    if (IN(6)) {
        pg8::Gemm g{H1B, (const bf16*)(ws + WS_WUP), M, FF, DM}; pg8::StaticOrder S; S.init(M, FF, F.G, (int)blockIdx.x);
        pg8::EpiBf<1> E{HID, FF, SSQ2, nullptr, nullptr};
        pg8::gemm_phase<pg8::EpiBf<1>, pg8::StaticOrder, true, true>(F.lds + RING_OFF, g, S, E);
        if (BOTH(6)) GRID_BAR(6);
    }
    if (IN(7)) {
        pg8::Gemm g{HID, (const bf16*)(ws + WS_WDN), M, DM, FF}; pg8::StaticOrder S; S.init(M, DM, F.G, (int)blockIdx.x);
        pg8::EpiRes3 E{H1B, H2B, SSQ3, DM};
        pg8::gemm_phase<pg8::EpiRes3, pg8::StaticOrder, true, true>(F.lds + RING_OFF, g, S, E);
        { pg8::Gemm g{PB, (const bf16*)(ws + WS_WP), M, DM, PLE}; pg8::StaticOrder S; S.init(M, DM, F.G, (int)blockIdx.x);
          pg8::EpiBf<2> E{PP, DM, nullptr, nullptr, nullptr};
          pg8::gemm_phase<pg8::EpiBf<2>, pg8::StaticOrder, true, true>(F.lds + RING_OFF, g, S, E); }
        if (BOTH(7)) GRID_BAR(7);
    }
    if (IN(8)) {
        pg8::Gemm g{H2B, (const bf16*)(ws + WS_WG), M, DM, DM}; pg8::StaticOrder S; S.init(M, DM, F.G, (int)blockIdx.x);
        pg8::EpiGate3 E{SSQ3, F.b_g, PP, H2B, F.out, DM};
        pg8::gemm_phase<pg8::EpiGate3, pg8::StaticOrder, true, true>(F.lds + RING_OFF, g, S, E);
    }
#undef IN
#undef BOTH
}

extern "C" void kernel_launch(void* const* d_in, const int* in_sizes, int n_in, void* d_out, int out_size, void* d_ws, size_t ws_size, hipStream_t stream) {
    static int grid = 0;
    if (grid == 0) {
        if (n_in != 22 || in_sizes[0] != M * DM || out_size != M * DM || ws_size < WS_END) { fprintf(stderr, "kernel_launch: unexpected shapes (n_in %d, in0 %d, out %d, ws %zu); nothing launched\n", n_in, n_in > 0 ? in_sizes[0] : -1, out_size, ws_size); grid = -1; return; }
        int dev = 0, cus = 0, per_cu = 0;
        if (hipGetDevice(&dev) != hipSuccess || hipDeviceGetAttribute(&cus, hipDeviceAttributeMultiprocessorCount, dev) != hipSuccess) { grid = -1; return; }
        if (hipFuncSetAttribute((const void*)fwd, hipFuncAttributeMaxDynamicSharedMemorySize, LDS_BYTES) != hipSuccess) { fprintf(stderr, "kernel_launch: hipFuncSetAttribute failed\n"); grid = -1; return; }
        if (hipOccupancyMaxActiveBlocksPerMultiprocessor(&per_cu, (const void*)fwd, NWAVES * 64, LDS_BYTES) != hipSuccess || per_cu < 1)
            fprintf(stderr, "kernel_launch: note: occupancy query reports %d workgroups per CU\n", per_cu);
        (void)hipGetLastError();
        grid = cus;
    }
    if (grid < 0) return;
    if (hipMemsetAsync((char*)d_ws + WS_CTL, 0, CTL_ZERO_BYTES, stream) != hipSuccess) { fprintf(stderr, "kernel_launch: hipMemsetAsync failed\n"); return; }
    Args a{};
    for (int i = 0; i < 22; ++i) a.in[i] = d_in[i];
    a.out = (float*)d_out; a.ws = (unsigned char*)d_ws;
    for (int li = 0; li < N_LAUNCHES; ++li) {
        a.ph_lo = (N_LAUNCHES == NPH) ? li : 0; a.ph_hi = (N_LAUNCHES == NPH) ? li + 1 : NPH; a.li = li;
        hipLaunchKernelGGL(fwd, dim3(grid), dim3(NWAVES * 64), LDS_BYTES, stream, a);
        const hipError_t le = hipPeekAtLastError();
        if (le != hipSuccess) { fprintf(stderr, "kernel_launch: launch %d failed: %s\n", li, hipGetErrorName(le)); break; }
    }
}
```
